# Optimizing an MI355X kernel written in HIP

```python
import jax, jax.numpy as jnp
from jax import lax
import numpy as np

D_MODEL = 1024
BATCH = 16
SEQ = 2048
DEPTH = 1

CHUNK = 64
Q_BLOCK = 128
HEAD_DIM = 64
N_HEADS_SB = 8
N_HEADS_FOX = 8
D_SB = N_HEADS_SB * HEAD_DIM
D_FOX = N_HEADS_FOX * HEAD_DIM
N_BRANCH = 2
IN_SIZES = (D_SB, D_SB, D_SB, D_SB,
            D_FOX, D_FOX, D_FOX, D_FOX,
            N_HEADS_FOX,
            N_BRANCH * D_MODEL)
D_IN = sum(IN_SIZES)
EPS = 1e-6
NEG_BIG = -1e30

kernel_name = "hybrid_stickbreaking_fox_gated_block"


def _rmsnorm(x, g):
    xf = x.astype(jnp.float32)
    inv = lax.rsqrt(jnp.mean(xf * xf, axis=-1, keepdims=True) + EPS)
    return (xf * inv).astype(x.dtype) * g


def _to_heads(t, n_heads):
    b, s, _ = t.shape
    return t.reshape(b, s, n_heads, HEAD_DIM).transpose(0, 2, 1, 3)


def _from_heads(t):
    b, h, s, d = t.shape
    return t.transpose(0, 2, 1, 3).reshape(b, s, h * d)


def _stick_breaking(q, k, v):
    s_len = q.shape[2]
    scale = HEAD_DIM ** -0.5
    outs = []
    for start in range(0, s_len, Q_BLOCK):
        end = start + Q_BLOCK
        qb, kb, vb = q[:, :, start:end], k[:, :, :end], v[:, :, :end]
        z = jnp.einsum('bhtd,bhsd->bhts', qb, kb).astype(jnp.float32) * scale
        t_idx = start + jnp.arange(Q_BLOCK)[:, None]
        s_idx = jnp.arange(end)[None, :]
        mask = s_idx < t_idx
        log_1m = jnp.where(mask, jax.nn.log_sigmoid(-z), 0.0)
        after = lax.cumsum(log_1m, axis=3, reverse=True) - log_1m
        w = jnp.where(mask, jnp.exp(jax.nn.log_sigmoid(z) + after), 0.0)
        outs.append(jnp.einsum('bhts,bhsd->bhtd', w.astype(vb.dtype), vb))
    return jnp.concatenate(outs, axis=2)


def _forgetting_attention(q, k, v, cum_log_f):
    s_len = q.shape[2]
    scale = HEAD_DIM ** -0.5
    outs = []
    for start in range(0, s_len, Q_BLOCK):
        end = start + Q_BLOCK
        qb, kb, vb = q[:, :, start:end], k[:, :, :end], v[:, :, :end]
        z = jnp.einsum('bhtd,bhsd->bhts', qb, kb).astype(jnp.float32) * scale
        z = z + cum_log_f[:, :, start:end, None] - cum_log_f[:, :, None, :end]
        t_idx = start + jnp.arange(Q_BLOCK)[:, None]
        s_idx = jnp.arange(end)[None, :]
        z = jnp.where(s_idx <= t_idx, z, NEG_BIG)
        p = jax.nn.softmax(z, axis=-1)
        outs.append(jnp.einsum('bhts,bhsd->bhtd', p.astype(vb.dtype), vb))
    return jnp.concatenate(outs, axis=2)


def setup_inputs(seed: int = 0) -> dict:
    key = jax.random.key(seed)
    ks = jax.random.split(key, 12)
    f32 = jnp.float32
    d = D_MODEL
    x = jax.random.normal(ks[0], (BATCH, SEQ, d), f32)
    c = jax.random.normal(ks[1], (BATCH, d), f32)
    w_ada = jax.random.normal(ks[2], (DEPTH, d, 3 * d), f32) * (0.5 * d ** -0.5)
    b_ada = 0.02 * jax.random.normal(ks[3], (DEPTH, 3 * d), f32)
    norm_g = 1.0 + 0.02 * jax.random.normal(ks[4], (DEPTH, d), f32)
    w_in = jax.random.normal(ks[5], (DEPTH, d, D_IN), f32) * d ** -0.5
    b_forget = jax.random.uniform(ks[6], (DEPTH, N_HEADS_FOX), f32, 1.0, 4.0)
    w_o_sb = jax.random.normal(ks[7], (DEPTH, D_SB, d), f32) * D_SB ** -0.5
    w_o_fox = jax.random.normal(ks[8], (DEPTH, D_FOX, d), f32) * D_FOX ** -0.5
    b_gate = 0.02 * jax.random.normal(ks[9], (DEPTH, N_BRANCH * d), f32)
    w_out = jax.random.normal(ks[10], (DEPTH, d, d), f32) * d ** -0.5
    final_g = 1.0 + 0.02 * jax.random.normal(ks[11], (d,), f32)
    return {"x": x, "c": c, "w_ada": w_ada, "b_ada": b_ada, "norm_g": norm_g,
            "w_in": w_in, "b_forget": b_forget, "w_o_sb": w_o_sb, "w_o_fox": w_o_fox,
            "b_gate": b_gate, "w_out": w_out, "final_g": final_g}


def reference(x, c, w_ada, b_ada, norm_g, w_in, b_forget, w_o_sb, w_o_fox, b_gate, w_out, final_g):
    b, s, d = x.shape
    split_points = list(np.cumsum(IN_SIZES)[:-1])
    for l in range(DEPTH):
        mod = c @ w_ada[l] + b_ada[l]
        shift, scale, gate = jnp.split(mod, 3, axis=-1)
        h = _rmsnorm(x, norm_g[l]) * (1.0 + scale[:, None, :]) + shift[:, None, :]

        proj = h @ w_in[l]
        (q_a, k_a, v_a, z_a, q_b, k_b, v_b, z_b,
         f_logit, g_logit) = jnp.split(proj, split_points, axis=-1)

        y_a = _from_heads(_stick_breaking(_to_heads(q_a, N_HEADS_SB), _to_heads(k_a, N_HEADS_SB),
                                          _to_heads(v_a, N_HEADS_SB)))
        y_a = (y_a * jax.nn.silu(z_a)) @ w_o_sb[l]

        log_f = jax.nn.log_sigmoid((f_logit + b_forget[l]).astype(jnp.float32))
        cum_log_f = jnp.cumsum(log_f, axis=1).transpose(0, 2, 1)
        y_b = _from_heads(_forgetting_attention(_to_heads(q_b, N_HEADS_FOX), _to_heads(k_b, N_HEADS_FOX),
                                                _to_heads(v_b, N_HEADS_FOX), cum_log_f))
        y_b = (y_b * jax.nn.silu(z_b)) @ w_o_fox[l]

        gates = jax.nn.sigmoid(g_logit + b_gate[l]).reshape(b, s, N_BRANCH, d)
        merged = gates[:, :, 0, :] * y_a + gates[:, :, 1, :] * y_b
        x = x + gate[:, None, :] * (merged @ w_out[l])
    return _rmsnorm(x, final_g)
```

```cpp
#include <hip/hip_runtime.h>
#include <cstdio>
#include <cstdint>
#include <cmath>
namespace pg8 {
#define PG8_LAS __attribute__((address_space(3)))
typedef unsigned short bf16_t;
typedef short bf16x8 __attribute__((ext_vector_type(8)));
typedef float f32x4 __attribute__((ext_vector_type(4)));
typedef unsigned u32x4 __attribute__((ext_vector_type(4)));
constexpr int BM = 256, BK = 64, HALF = 128, HTB = HALF * BK * 2  , STAGE_BYTES = 8 * HTB, NXCD = 8, WGM = 8;

__host__ __device__ __forceinline__ int lds_byte(int r, int c) { const int st = (r >> 4) * 2 + (c >> 5), rr = r & 15, cc = c & 31, ob = rr * 64 + cc * 2; return st * 1024 + (ob ^ (((ob >> 9) & 1) << 5)); }
__host__ __device__ __forceinline__ void stage_rc(int b, int& R, int& C) { const int st = b / 1024, sb = b % 1024, swz = sb ^ (((sb >> 9) & 1) << 5); R = (st >> 1) * 16 + swz / 64; C = (st & 1) * 32 + (swz % 64) / 2; }
__host__ __device__ __forceinline__ int perm32(int rho) { const int n = rho >> 4, i = rho & 15; return 8 * (i >> 2) + 4 * n + (i & 3); }

struct Unit { int pm, pn; };
struct Gemm { const bf16_t* A; const bf16_t* Bt; int M, N, K, lda, ldb; };

struct StaticOrder {
    int nM, nN, nwg, G, c;
    __host__ __device__ void init(int M, int N, int G_, int c_) { nM = M / BM; nN = N / BM; nwg = nM * nN; G = G_; c = c_; }
    __host__ __device__ bool next(int i, Unit& u) const {
        const long L = (long)i * G + c; if (L >= nwg) return false;
        int wgid = (int)L; { const int q = nwg / NXCD, r = nwg % NXCD, xcd = wgid % NXCD, off = wgid / NXCD; wgid = (xcd < r ? xcd * (q + 1) : r * (q + 1) + (xcd - r) * q) + off; }
        const int nig = WGM * nN, gid = wgid / nig, fm = gid * WGM, gsz = (nM - fm) < WGM ? (nM - fm) : WGM;
        u.pm = fm + ((wgid % nig) % gsz); u.pn = (wgid % nig) / gsz; return true;
    }
    __device__ __forceinline__ void a_ready(const Unit&) const {}
    __device__ __forceinline__ void done(const Unit&) const {}
};


__device__ __forceinline__ unsigned cvt_pk_bf16(float lo, float hi) { unsigned r; asm volatile("v_cvt_pk_bf16_f32 %0, %1, %2" : "=v"(r) : "v"(lo), "v"(hi)); return r; }
__device__ __forceinline__ float bf_lo(unsigned w) { return __builtin_bit_cast(float, w << 16); }
__device__ __forceinline__ float bf_hi(unsigned w) { return __builtin_bit_cast(float, w & 0xffff0000u); }
__device__ __forceinline__ float sigmoid_f(float v) { return __builtin_amdgcn_rcpf(1.0f + __builtin_amdgcn_exp2f(-1.4426950408889634f * v)); }

struct EpiProj {
    static constexpr bool PERM = true, AFTER_DRAIN = false;
    bf16_t* QKVZ; size_t sec_stride; bf16_t* GATES; const float* b_gate; float qscale;
    __device__ __forceinline__ void operator()(const f32x4 (&acc)[2][2][4][2], const Unit& u, int wr, int wc, int fr, int fq) const {
        const int sec = u.pn >> 1; const int row0 = u.pm * BM + wr * 64 + fr;
        bf16_t* base; int ldc, col0; int mode; float sc = 1.f;
        if (sec < 8) { base = QKVZ + (size_t)sec * sec_stride; ldc = 512; col0 = (u.pn & 1) * 256 + wc * 32 + 8 * fq; mode = ((sec & 3) == 3) ? 1 : 0; if ((sec & 3) == 0) sc = qscale; }
        else { base = GATES; ldc = 2048; col0 = (u.pn - 16) * 256 + wc * 32 + 8 * fq; mode = 2; }
        f32x4 bv[2][2];
#pragma unroll
        for (int bj = 0; bj < 2; ++bj)
#pragma unroll
            for (int n = 0; n < 2; ++n) bv[bj][n] = (mode == 2) ? *(const f32x4*)(b_gate + col0 + bj * HALF + 4 * n) : (f32x4){0.f, 0.f, 0.f, 0.f};
#pragma unroll
        for (int ai = 0; ai < 2; ++ai)
#pragma unroll
            for (int m = 0; m < 4; ++m) { bf16_t* rowp = base + (size_t)(row0 + ai * HALF + m * 16) * ldc + col0;
#pragma unroll
                for (int bj = 0; bj < 2; ++bj) { f32x4 v0 = acc[ai][bj][m][0] + bv[bj][0], v1 = acc[ai][bj][m][1] + bv[bj][1];
                    if (mode != 0) {
#pragma unroll
                        for (int e = 0; e < 4; ++e) { const float s0 = sigmoid_f(v0[e]), s1 = sigmoid_f(v1[e]); v0[e] = (mode == 2) ? s0 : v0[e] * s0; v1[e] = (mode == 2) ? s1 : v1[e] * s1; } }
                    v0 = v0 * sc; v1 = v1 * sc; u32x4 w; w.x = cvt_pk_bf16(v0[0], v0[1]); w.y = cvt_pk_bf16(v0[2], v0[3]); w.z = cvt_pk_bf16(v1[0], v1[1]); w.w = cvt_pk_bf16(v1[2], v1[3]);
                    *(u32x4*)(rowp + bj * HALF) = w; } }
    }
};
struct EpiGateF32 {
    static constexpr bool PERM = false, AFTER_DRAIN = false;
    float* T; const bf16_t* G; int goff;
    __device__ __forceinline__ void operator()(const f32x4 (&acc)[2][2][4][2], const Unit& u, int wr, int wc, int fr, int fq) const {
        const int row0 = u.pm * BM + wr * 64 + fr, col0 = u.pn * BM + wc * 32 + 4 * fq;
#pragma unroll
        for (int ai = 0; ai < 2; ++ai)
#pragma unroll
            for (int m = 0; m < 4; ++m) { const size_t r = (size_t)(row0 + ai * HALF + m * 16);
#pragma unroll
                for (int bj = 0; bj < 2; ++bj)
#pragma unroll
                    for (int n = 0; n < 2; ++n) { const int c = col0 + bj * HALF + n * 16; const uint2 gw = *(const uint2*)(G + r * 2048 + goff + c);
                        f32x4 v = acc[ai][bj][m][n]; v[0] *= bf_lo(gw.x); v[1] *= bf_hi(gw.x); v[2] *= bf_lo(gw.y); v[3] *= bf_hi(gw.y);
                        *(f32x4*)(T + r * 1024 + c) = v; } }
    }
};
struct EpiMerge {
    static constexpr bool PERM = true, AFTER_DRAIN = false;
    const float* T; const bf16_t* G; int goff; bf16_t* O;
    __device__ __forceinline__ void operator()(const f32x4 (&acc)[2][2][4][2], const Unit& u, int wr, int wc, int fr, int fq) const {
        const int row0 = u.pm * BM + wr * 64 + fr, col0 = u.pn * BM + wc * 32 + 8 * fq;
#pragma unroll
        for (int ai = 0; ai < 2; ++ai)
#pragma unroll
            for (int m = 0; m < 4; ++m) { const size_t r = (size_t)(row0 + ai * HALF + m * 16);
#pragma unroll
                for (int bj = 0; bj < 2; ++bj) { const int c = col0 + bj * HALF; const u32x4 gw = *(const u32x4*)(G + r * 2048 + goff + c);
                    const f32x4 t0 = *(const f32x4*)(T + r * 1024 + c), t1 = *(const f32x4*)(T + r * 1024 + c + 4);
                    f32x4 v0 = acc[ai][bj][m][0], v1 = acc[ai][bj][m][1];
                    v0[0] = t0[0] + v0[0] * bf_lo(gw.x); v0[1] = t0[1] + v0[1] * bf_hi(gw.x); v0[2] = t0[2] + v0[2] * bf_lo(gw.y); v0[3] = t0[3] + v0[3] * bf_hi(gw.y);
                    v1[0] = t1[0] + v1[0] * bf_lo(gw.z); v1[1] = t1[1] + v1[1] * bf_hi(gw.z); v1[2] = t1[2] + v1[2] * bf_lo(gw.w); v1[3] = t1[3] + v1[3] * bf_hi(gw.w);
                    u32x4 w; w.x = cvt_pk_bf16(v0[0], v0[1]); w.y = cvt_pk_bf16(v0[2], v0[3]); w.z = cvt_pk_bf16(v1[0], v1[1]); w.w = cvt_pk_bf16(v1[2], v1[3]);
                    *(u32x4*)(O + r * 1024 + c) = w; } }
    }
};
struct EpiResid {
    static constexpr bool PERM = false, AFTER_DRAIN = false;
    const float* X; const float* MOD; float* O; int rows_per_b;
    __device__ __forceinline__ void operator()(const f32x4 (&acc)[2][2][4][2], const Unit& u, int wr, int wc, int fr, int fq) const {
        const int row0 = u.pm * BM + wr * 64 + fr, col0 = u.pn * BM + wc * 32 + 4 * fq;
        const int b = (u.pm * BM) / rows_per_b;
        f32x4 gv[2][2];
#pragma unroll
        for (int bj = 0; bj < 2; ++bj)
#pragma unroll
            for (int n = 0; n < 2; ++n) gv[bj][n] = *(const f32x4*)(MOD + (size_t)b * 3072 + 2048 + col0 + bj * HALF + n * 16);
#pragma unroll
        for (int ai = 0; ai < 2; ++ai)
#pragma unroll
            for (int m = 0; m < 4; ++m) { const size_t r = (size_t)(row0 + ai * HALF + m * 16);
#pragma unroll
                for (int bj = 0; bj < 2; ++bj)
#pragma unroll
                    for (int n = 0; n < 2; ++n) { const int c = col0 + bj * HALF + n * 16; const f32x4 xv = *(const f32x4*)(X + r * 1024 + c);
                        *(f32x4*)(O + r * 1024 + c) = xv + gv[bj][n] * acc[ai][bj][m][n]; } }
    }
};

template <class Epi, class Sched, bool ALIGN_EPI = false, bool SP2 = false>
__device__ __forceinline__ void gemm_phase(PG8_LAS unsigned char* lds, const Gemm g, const Sched& S, const Epi& E) {
    const int tid = threadIdx.x, wid = __builtin_amdgcn_readfirstlane(tid >> 6), lane = tid & 63, wr = wid >> 2, wc = wid & 3, fr = lane & 15, fq = lane >> 4;
    const int K = g.K, nt = K / BK;
    unsigned voffA[2], voffB[2];
#pragma unroll
    for (int i = 0; i < 2; ++i) { int R, C; stage_rc(tid * 16 + i * 8192, R, C); const int Rb = Epi::PERM ? ((R & ~31) + perm32(R & 31)) : R;
        voffA[i] = (unsigned)(R * g.lda + C) * 2u; voffB[i] = (unsigned)(Rb * g.ldb + C) * 2u; }
    const size_t kstep = (size_t)(BK * 2);
    const size_t hstepA = (size_t)HALF * g.lda * 2, hstepB = (size_t)HALF * g.ldb * 2;
    const size_t tstepA = 2 * hstepA, tstepB = 2 * hstepB;
    const unsigned ldsw = (unsigned)wid * 1024u;
    const int aoff = lds_byte(wr * 64 + fr, fq * 8), boff = lds_byte(wc * 32 + fr, fq * 8);
#define PG8_SA(b, h) (((b) * 2 + (h)) * HTB)
#define PG8_SB(b, h) ((4 + (b) * 2 + (h)) * HTB)
#define PG8_STAGE(bufoff, gbase, voff) do { _Pragma("unroll") for (int _i = 0; _i < 2; ++_i) \
        __builtin_amdgcn_global_load_lds((const unsigned*)((const char*)(gbase) + (voff)[_i]), (PG8_LAS unsigned*)(lds + (bufoff) + ldsw + _i * 8192), 16, 0, 0); } while (0)
#define PG8_LDA(dst, b, h) do { _Pragma("unroll") for (int m = 0; m < 4; ++m) _Pragma("unroll") for (int k = 0; k < 2; ++k) dst[m][k] = *(const PG8_LAS bf16x8*)(lds + PG8_SA(b, h) + aoff + m * 2048 + k * 1024); } while (0)
#define PG8_LDB(dst, b, h) do { _Pragma("unroll") for (int n = 0; n < 2; ++n) _Pragma("unroll") for (int k = 0; k < 2; ++k) dst[n][k] = *(const PG8_LAS bf16x8*)(lds + PG8_SB(b, h) + boff + n * 2048 + k * 1024); } while (0)
#define PG8_MMA(ai, bj, At, Bt) do { __builtin_amdgcn_s_setprio(1); _Pragma("unroll") for (int m = 0; m < 4; ++m) _Pragma("unroll") for (int n = 0; n < 2; ++n) _Pragma("unroll") for (int k = 0; k < 2; ++k) \
        acc[ai][bj][m][n] = __builtin_amdgcn_mfma_f32_16x16x32_bf16(Bt[n][k], At[m][k], acc[ai][bj][m][n], 0, 0, 0); __builtin_amdgcn_s_setprio(0); } while (0)
#define PG8_WAIT_V(n) asm volatile("s_waitcnt vmcnt(" #n ")" ::: "memory")
#define PG8_WAIT_L(n) asm volatile("s_waitcnt lgkmcnt(" #n ")" ::: "memory")
#define PG8_BAR __builtin_amdgcn_s_barrier()
#define PG8_SCHED __builtin_amdgcn_sched_barrier(0)
    Unit cur, nxt; int ui = 0;
    if (!S.next(0, cur)) return;
    f32x4 acc[2][2][4][2];
#pragma unroll
    for (int a = 0; a < 2; ++a)
#pragma unroll
        for (int b = 0; b < 2; ++b)
#pragma unroll
            for (int m = 0; m < 4; ++m)
#pragma unroll
                for (int n = 0; n < 2; ++n) acc[a][b][m][n] = (f32x4){0.f, 0.f, 0.f, 0.f};
    bf16x8 At[4][2], B0[2][2], B1[2][2];
    const char* cA = (const char*)g.A + (size_t)cur.pm * tstepA; const char* cB = (const char*)g.Bt + (size_t)cur.pn * tstepB;
    S.a_ready(cur);
    if constexpr (SP2) {
        PG8_STAGE(PG8_SB(0, 0), cB, voffB); PG8_STAGE(PG8_SB(0, 1), cB + hstepB, voffB); PG8_STAGE(PG8_SA(0, 0), cA, voffA); PG8_STAGE(PG8_SA(0, 1), cA + hstepA, voffA);
        if (wr == 1) PG8_BAR;
        PG8_WAIT_V(2); PG8_BAR;
        PG8_STAGE(PG8_SB(1, 0), cB + kstep, voffB); PG8_STAGE(PG8_SA(1, 0), cA + kstep, voffA); PG8_STAGE(PG8_SB(1, 1), cB + hstepB + kstep, voffB);
        PG8_WAIT_V(6); PG8_BAR;
    } else {
        PG8_STAGE(PG8_SB(0, 0), cB, voffB); PG8_STAGE(PG8_SA(0, 0), cA, voffA); PG8_STAGE(PG8_SB(0, 1), cB + hstepB, voffB); PG8_STAGE(PG8_SA(0, 1), cA + hstepA, voffA);
        if (wr == 1) PG8_BAR;
        PG8_WAIT_V(4); PG8_BAR;
        PG8_STAGE(PG8_SB(1, 0), cB + kstep, voffB); PG8_STAGE(PG8_SA(1, 0), cA + kstep, voffA); PG8_STAGE(PG8_SB(1, 1), cB + hstepB + kstep, voffB);
        PG8_WAIT_V(6); PG8_BAR;
    }
    for (;;) {
        const bool has_next = S.next(ui + 1, nxt);
        const char* nA = has_next ? (const char*)g.A + (size_t)nxt.pm * tstepA : cA; const char* nB = has_next ? (const char*)g.Bt + (size_t)nxt.pn * tstepB : cB;
        for (int t = 0; t < nt; t += 2) {
            const bool last = (t == nt - 2);
            const char* a1 = cA + (size_t)(t + 1) * kstep;
            const char* a2 = last ? nA : cA + (size_t)(t + 2) * kstep; const char* b2 = last ? nB : cB + (size_t)(t + 2) * kstep;
            const char* a3 = a2 + kstep; const char* b3 = b2 + kstep;
            if (last && has_next) S.a_ready(nxt);
            if constexpr (SP2) {
            PG8_LDB(B0, 0, 0); PG8_LDB(B1, 0, 1); PG8_SCHED; PG8_LDA(At, 0, 0); PG8_STAGE(PG8_SA(1, 1), a1 + hstepA, voffA);
            PG8_WAIT_V(8); PG8_WAIT_L(0); PG8_BAR; PG8_MMA(0, 0, At, B0); PG8_MMA(0, 1, At, B1); PG8_BAR; PG8_SCHED;
            PG8_LDA(At, 0, 1); PG8_STAGE(PG8_SB(0, 0), b2, voffB); PG8_STAGE(PG8_SB(0, 1), b2 + hstepB, voffB); PG8_STAGE(PG8_SA(0, 0), a2, voffA);
            PG8_WAIT_V(8); PG8_WAIT_L(0); PG8_BAR; PG8_MMA(1, 0, At, B0); PG8_MMA(1, 1, At, B1); PG8_BAR; PG8_SCHED;
            PG8_LDB(B0, 1, 0); PG8_LDB(B1, 1, 1); PG8_SCHED; PG8_LDA(At, 1, 0); PG8_STAGE(PG8_SA(0, 1), a2 + hstepA, voffA);
            PG8_WAIT_V(8); PG8_WAIT_L(0); PG8_BAR; PG8_MMA(0, 0, At, B0); PG8_MMA(0, 1, At, B1); PG8_BAR; PG8_SCHED;
            PG8_LDA(At, 1, 1); PG8_STAGE(PG8_SB(1, 0), b3, voffB); PG8_STAGE(PG8_SB(1, 1), b3 + hstepB, voffB); PG8_STAGE(PG8_SA(1, 0), a3, voffA);
            PG8_WAIT_V(8); PG8_WAIT_L(0); PG8_BAR; PG8_MMA(1, 0, At, B0); PG8_MMA(1, 1, At, B1); PG8_BAR; PG8_SCHED;
            } else {
            PG8_LDB(B0, 0, 0); PG8_SCHED; PG8_LDA(At, 0, 0); PG8_STAGE(PG8_SA(1, 1), a1 + hstepA, voffA);
            PG8_WAIT_L(8); PG8_BAR; PG8_WAIT_L(0); PG8_MMA(0, 0, At, B0); PG8_BAR; PG8_SCHED;
            PG8_LDB(B1, 0, 1); PG8_STAGE(PG8_SB(0, 0), b2, voffB);
            PG8_BAR; PG8_WAIT_L(0); PG8_MMA(0, 1, At, B1); PG8_BAR;
            PG8_LDA(At, 0, 1); PG8_STAGE(PG8_SA(0, 0), a2, voffA);
            PG8_BAR; PG8_WAIT_L(0); PG8_MMA(1, 0, At, B0); PG8_BAR; PG8_SCHED;
            PG8_STAGE(PG8_SB(0, 1), b2 + hstepB, voffB);
            PG8_WAIT_V(6); PG8_BAR; PG8_MMA(1, 1, At, B1); PG8_BAR;
            PG8_LDB(B0, 1, 0); PG8_SCHED; PG8_LDA(At, 1, 0); PG8_STAGE(PG8_SA(0, 1), a2 + hstepA, voffA);
            PG8_WAIT_L(8); PG8_BAR; PG8_WAIT_L(0); PG8_MMA(0, 0, At, B0); PG8_BAR; PG8_SCHED;
            PG8_LDB(B1, 1, 1); PG8_STAGE(PG8_SB(1, 0), b3, voffB);
            PG8_BAR; PG8_WAIT_L(0); PG8_MMA(0, 1, At, B1); PG8_BAR;
            PG8_LDA(At, 1, 1); PG8_STAGE(PG8_SA(1, 0), a3, voffA);
            PG8_BAR; PG8_WAIT_L(0); PG8_MMA(1, 0, At, B0); PG8_BAR; PG8_SCHED;
            PG8_STAGE(PG8_SB(1, 1), b3 + hstepB, voffB);
            PG8_WAIT_V(6); PG8_BAR; PG8_MMA(1, 1, At, B1); PG8_BAR;
            }
        }
        if constexpr (ALIGN_EPI) { if (wr == 0) PG8_BAR; }
        if constexpr (!Epi::AFTER_DRAIN) { E(acc, cur, wr, wc, fr, fq); S.done(cur); }
        if (!has_next) break;
#pragma unroll
        for (int a = 0; a < 2; ++a)
#pragma unroll
            for (int b = 0; b < 2; ++b)
#pragma unroll
                for (int m = 0; m < 4; ++m)
#pragma unroll
                    for (int n = 0; n < 2; ++n) acc[a][b][m][n] = (f32x4){0.f, 0.f, 0.f, 0.f};
        cur = nxt; cA = nA; cB = nB; ++ui;
        if constexpr (ALIGN_EPI) { if (wr == 1) PG8_BAR; }
    }
    PG8_WAIT_V(0);
    if constexpr (!ALIGN_EPI) { if (wr == 0) PG8_BAR; }
    PG8_BAR;
    if constexpr (Epi::AFTER_DRAIN) { E.fused(acc, cur, wr, wc, fr, fq, lds, wid, lane); S.done(cur); }
#undef PG8_SA
#undef PG8_SB
#undef PG8_STAGE
#undef PG8_LDA
#undef PG8_LDB
#undef PG8_MMA
#undef PG8_WAIT_V
#undef PG8_WAIT_L
#undef PG8_BAR
#undef PG8_SCHED
}
}

#define GAS __attribute__((address_space(1)))
#define LAS __attribute__((address_space(3)))
typedef unsigned short bf16;
typedef unsigned v4u __attribute__((ext_vector_type(4)));
typedef float f32x4 __attribute__((ext_vector_type(4)));
typedef short bf16x8 __attribute__((ext_vector_type(8)));
typedef GAS unsigned gu32;
typedef GAS unsigned long long gu64;
#define RLX_AGENT __ATOMIC_RELAXED, __HIP_MEMORY_SCOPE_AGENT
#define LDS_WAIT() asm volatile("s_waitcnt lgkmcnt(0)" ::: "memory")
#define VM_WAIT() asm volatile("s_waitcnt vmcnt(0)" ::: "memory")
__device__ __forceinline__ unsigned long long rt() { return __builtin_amdgcn_s_memrealtime(); }
__device__ __forceinline__ unsigned f2bf(float f) { unsigned u = __builtin_bit_cast(unsigned, f); return (u + 0x7fffu + ((u >> 16) & 1u)) >> 16; }
__device__ __forceinline__ unsigned pk2(float lo, float hi) { return f2bf(lo) | (f2bf(hi) << 16); }

#define XB_TMO      128
#define XB_XCNT(j)  (256  + 64 * (j))
#define XB_XSUB(j)  (1280 + 64 * (j))
#define XB_XGEN(j)  (2304 + 64 * (j))
#define XB_TOP      3328
#define XB_TOPGEN   3392
#define XCD_BAR_WORDS 3456
#define XB_SPIN_CAP (1u << 18)

__device__ __forceinline__ unsigned xb_ld(unsigned* p)              { return __hip_atomic_load(p, __ATOMIC_RELAXED, __HIP_MEMORY_SCOPE_AGENT); }
__device__ __forceinline__ unsigned xb_add(unsigned* p, unsigned v) { return __hip_atomic_fetch_add(p, v, __ATOMIC_RELAXED, __HIP_MEMORY_SCOPE_AGENT); }
__device__ __forceinline__ unsigned xb_xcc_id() { return (unsigned)__builtin_amdgcn_s_getreg((3 << 11) | 20) & 0xFu; }
#define XB_SPIN(cond, bar) do { unsigned _sp = 0; while (cond) { __builtin_amdgcn_s_sleep(1); \
    if ((++_sp & 255u) == 0u) { if (xb_ld(&(bar)[XB_TMO])) break; if (_sp > XB_SPIN_CAP) { atomicAdd(&(bar)[XB_TMO], 1u); break; } } } } while (0)

struct XcdBarrier {
    unsigned* bar; unsigned x;
    volatile LAS unsigned* st;
};

__device__ __forceinline__ XcdBarrier xcd_barrier_post(unsigned* bar, volatile LAS unsigned* st) {
    XcdBarrier b; b.bar = bar; b.x = xb_xcc_id(); b.st = st;
    if (threadIdx.x == 0) (void)xb_add(&bar[XB_XCNT(b.x)], 1u);
    return b;
}
__device__ __forceinline__ void xcd_barrier_complete(unsigned* bar, unsigned x, unsigned& nloc, unsigned& nx) {
    const unsigned G = gridDim.x * gridDim.y * gridDim.z;
    unsigned sum, cnt, mine, sp = 0u;
    for (;;) {
        sum = 0u; cnt = 0u; mine = 0u;
#pragma unroll
        for (unsigned j = 0; j < 16; ++j) { const unsigned c = xb_ld(&bar[XB_XCNT(j)]); sum += c; cnt += (c > 0u) ? 1u : 0u; mine = (j == x) ? c : mine; }
        if (sum == G) break;
        __builtin_amdgcn_s_sleep(1);
        if ((++sp & 255u) == 0u) { if (xb_ld(&bar[XB_TMO])) break; if (sp > XB_SPIN_CAP) { atomicAdd(&bar[XB_TMO], 1u); break; } }
    }
    nloc = mine > 0u ? mine : 1u; nx = cnt > 0u ? cnt : 1u;
}

__device__ __forceinline__ void xcd_barrier(const XcdBarrier& b) {
    asm volatile("s_waitcnt vmcnt(0)" ::: "memory");
    __syncthreads();
    if (threadIdx.x == 0) {
        unsigned* bar = b.bar;
        __builtin_amdgcn_s_waitcnt(0);
        unsigned nloc = b.st[0], nx = b.st[1];
        if (nloc == 0u) { xcd_barrier_complete(bar, b.x, nloc, nx); b.st[0] = nloc; b.st[1] = nx; }
        const unsigned old = xb_add(&bar[XB_XSUB(b.x)], 1u);
        const unsigned gen = old / nloc;
        if (old + 1u == (gen + 1u) * nloc) {
            __builtin_amdgcn_fence(__ATOMIC_RELEASE, "agent");
            asm volatile("s_waitcnt vmcnt(0)" ::: "memory");
            const unsigned og = xb_add(&bar[XB_TOP], 1u);
            const unsigned tg = og / nx;
            if (og + 1u == (tg + 1u) * nx) xb_add(&bar[XB_TOPGEN], 1u);
            else XB_SPIN(xb_ld(&bar[XB_TOPGEN]) == tg, bar);
            __builtin_amdgcn_fence(__ATOMIC_ACQUIRE, "agent");
            xb_add(&bar[XB_XGEN(b.x)], 1u);
            asm volatile("s_waitcnt vmcnt(0)" ::: "memory");
        } else {
            XB_SPIN(xb_ld(&bar[XB_XGEN(b.x)]) == gen, bar);
            __builtin_amdgcn_fence(__ATOMIC_ACQUIRE, "agent");
            asm volatile("s_waitcnt vmcnt(0)" ::: "memory");
        }
    }
    __syncthreads();
}


constexpr int NWAVES = 8;
constexpr int BATCH = 16, SEQ = 2048, D = 1024, M = BATCH * SEQ, NH = 8, HD = 64, DSEC = 512;
constexpr int DIN = 6152, NPROJ = 6144, NGATE = 2048;
constexpr float RMS_EPS = 1e-6f;
constexpr float LOG2E = 1.4426950408889634f;
constexpr float C2 = 0.125f * LOG2E;
constexpr float SB_STOP = 64.0f;

constexpr size_t MiB = 1u << 20;
constexpr size_t WS_CTL = 0, CTL_ZERO_BYTES = 1 * MiB;
constexpr size_t WS_MOD = 1 * MiB;
constexpr size_t WS_LOGF = 2 * MiB;
constexpr size_t WS_F2 = 3 * MiB;
constexpr size_t WS_WIN = 4 * MiB;
constexpr size_t WS_WO = 16 * MiB;
constexpr size_t WS_WOUT = 18 * MiB;
constexpr size_t WS_WF = 20 * MiB;
constexpr size_t WS_HY = 32 * MiB;
constexpr size_t WS_QKVZ = 96 * MiB;
constexpr size_t SEC_ELEMS = (size_t)M * DSEC;
constexpr size_t WS_GATES = 352 * MiB;
constexpr size_t WS_MERGED = WS_QKVZ;
constexpr size_t WS_END = 480 * MiB;

constexpr int CW_BAR = 4096;

constexpr int RING_OFF = 0, RING_BYTES = 131072;
constexpr int LDSCTL_OFF = RING_BYTES, MISC_OFF = LDSCTL_OFF + 320;
constexpr int LDS_BYTES = 147456;

struct Frame {
    LAS unsigned char* lds;
    volatile LAS unsigned* MISC;
    gu32* ctl;
    int tid, lane, wave;
    int vcu, G;
    const float *x, *c, *w_ada, *b_ada, *norm_g, *w_in, *b_forget, *w_o_sb, *w_o_fox, *b_gate, *w_out, *final_g;
    float* out;
    float *MOD, *LOGF, *F2, *WF;
    bf16 *WIN_T, *WO_T, *WOUT_T, *HY, *QKVZ, *GATES, *MERGED;
};

__device__ __forceinline__ float wave_sum(float v) {
#pragma unroll
    for (int o = 1; o < 64; o <<= 1) v += __shfl_xor(v, o);
    return v;
}

__device__ __forceinline__ void transpose_item(const float* W, int ldw, int src_col0, bf16* WT, int ldt, int dst_row0, int dst_col0, LAS float* scr, int kb, int nb, int lane) {
    const int k0 = 64 * kb, n0 = 32 * nb;
#pragma unroll 8
    for (int i = 0; i < 32; ++i) { const int kk = 2 * i + (lane >> 5); scr[kk * 33 + (lane & 31)] = W[(size_t)(k0 + kk) * ldw + src_col0 + n0 + (lane & 31)]; }
    LDS_WAIT(); asm volatile("" ::: "memory");
    const int c = lane & 7;
#pragma unroll
    for (int j = 0; j < 4; ++j) { const int n = (lane >> 3) + 8 * j; const LAS float* s = scr + (8 * c) * 33 + n;
        v4u o; o.x = pk2(s[0 * 33], s[1 * 33]); o.y = pk2(s[2 * 33], s[3 * 33]); o.z = pk2(s[4 * 33], s[5 * 33]); o.w = pk2(s[6 * 33], s[7 * 33]);
        *(GAS v4u*)(WT + (size_t)(dst_row0 + n0 + n) * ldt + dst_col0 + k0 + 8 * c) = o; }
    LDS_WAIT(); asm volatile("" ::: "memory");
}
__device__ __forceinline__ void ph_p0a(Frame& F) {
    if (blockIdx.x < 96) {
        LAS float* cl = (LAS float*)(F.lds + RING_OFF);
        for (int i = F.tid; i < 16 * 1024 / 4; i += NWAVES * 64) ((LAS f32x4*)cl)[i] = ((const GAS f32x4*)F.c)[i];
        __syncthreads();
        const int col = F.tid & 31, ks = F.tid >> 5, j = blockIdx.x * 32 + col;
        float acc[16];
#pragma unroll
        for (int b = 0; b < 16; ++b) acc[b] = 0.f;
#pragma unroll 4
        for (int i = 0; i < 64; ++i) { const int k = ks * 64 + i; const float w = F.w_ada[(size_t)k * 3072 + j];
#pragma unroll
            for (int b = 0; b < 16; ++b) acc[b] += cl[b * 1024 + k] * w; }
        LAS float* red = cl + 16384;
#pragma unroll
        for (int b = 0; b < 16; ++b) red[(ks * 16 + b) * 32 + col] = acc[b];
        __syncthreads();
        { const int b = F.tid >> 5; float s = 0.f;
#pragma unroll
          for (int k2 = 0; k2 < 16; ++k2) s += red[(k2 * 16 + b) * 32 + col];
          F.MOD[b * 3072 + j] = s + F.b_ada[j]; }
        __syncthreads();
    }
    { const int g = blockIdx.x * (NWAVES * 64) + F.tid; if (g < 8192) { const int e = g >> 10, k = g & 1023; F.WF[g] = F.w_in[(size_t)k * DIN + 4096 + e]; } }
    LAS float* scr = (LAS float*)(F.lds + RING_OFF + F.wave * 16384);
    const int gw = F.vcu * NWAVES + F.wave, NGW = F.G * NWAVES;
    constexpr int I_A = 16 * 128, I_B = 16 * 64, I_O = 8 * 32, I_W = 16 * 32;
    constexpr int NITEMS = I_A + I_B + 2 * I_O + I_W;
    for (int it = gw; it < NITEMS; it += NGW) {
        int r = it;
        if (r < I_A) { transpose_item(F.w_in, DIN, 0, F.WIN_T, 1024, 0, 0, scr, r / 128, r % 128, F.lane); continue; } r -= I_A;
        if (r < I_B) { transpose_item(F.w_in, DIN, 4104, F.WIN_T, 1024, 4096, 0, scr, r / 64, r % 64, F.lane); continue; } r -= I_B;
        if (r < I_O) { transpose_item(F.w_o_sb, 1024, 0, F.WO_T, 1024, 0, 0, scr, r / 32, r % 32, F.lane); continue; } r -= I_O;
        if (r < I_O) { transpose_item(F.w_o_fox, 1024, 0, F.WO_T, 1024, 0, 512, scr, r / 32, r % 32, F.lane); continue; } r -= I_O;
        transpose_item(F.w_out, 1024, 0, F.WOUT_T, 1024, 0, 0, scr, r / 32, r % 32, F.lane);
    }
}

__device__ __forceinline__ void ph_p0b(Frame& F) {
    LAS float* wf = (LAS float*)(F.lds + RING_OFF);
    for (int i = F.tid; i < 8192 / 4; i += NWAVES * 64) ((LAS f32x4*)wf)[i] = ((const GAS f32x4*)F.WF)[i];
    __syncthreads();
    const int gw = F.vcu * NWAVES + F.wave, NGW = F.G * NWAVES;
    const int lane = F.lane;
    for (int blk = gw; blk < M / 16; blk += NGW) {
        const int row0 = blk * 16, b = row0 / SEQ;
        f32x4 ga[4], sh[4];
#pragma unroll
        for (int j = 0; j < 4; ++j) { const int col = 256 * j + 4 * lane;
            const f32x4 g = *(const GAS f32x4*)(F.norm_g + col), sc = *(const GAS f32x4*)(F.MOD + b * 3072 + 1024 + col);
            ga[j] = g * (1.0f + sc); sh[j] = *(const GAS f32x4*)(F.MOD + b * 3072 + col); }
        for (int r = 0; r < 16; ++r) {
            const int row = row0 + r;
            const GAS f32x4* xr = (const GAS f32x4*)(F.x + (size_t)row * D) + lane;
            f32x4 v[4]; float s = 0.f;
#pragma unroll
            for (int j = 0; j < 4; ++j) { v[j] = xr[64 * j]; s += (v[j].x * v[j].x + v[j].y * v[j].y) + (v[j].z * v[j].z + v[j].w * v[j].w); }
            const float inv = 1.0f / sqrtf(wave_sum(s) * (1.0f / D) + RMS_EPS);
            GAS unsigned long long* o8 = (GAS unsigned long long*)(F.HY + (size_t)row * D) + lane;
            float p[8];
#pragma unroll
            for (int e = 0; e < 8; ++e) p[e] = 0.f;
#pragma unroll
            for (int j = 0; j < 4; ++j) { const f32x4 h = (v[j] * inv) * ga[j] + sh[j];
                o8[64 * j] = (unsigned long long)pk2(h.x, h.y) | ((unsigned long long)pk2(h.z, h.w) << 32);
#pragma unroll
                for (int e = 0; e < 8; ++e) { const f32x4 w = *(const LAS f32x4*)(wf + e * 1024 + 256 * j + 4 * lane); p[e] += (h.x * w.x + h.y * w.y) + (h.z * w.z + h.w * w.w); } }
            const bool u5 = (lane & 32) != 0, u4 = (lane & 16) != 0, u3 = (lane & 8) != 0;
            float q0 = (u5 ? p[4] : p[0]) + __shfl_xor(u5 ? p[0] : p[4], 32);
            float q1 = (u5 ? p[5] : p[1]) + __shfl_xor(u5 ? p[1] : p[5], 32);
            float q2 = (u5 ? p[6] : p[2]) + __shfl_xor(u5 ? p[2] : p[6], 32);
            float q3 = (u5 ? p[7] : p[3]) + __shfl_xor(u5 ? p[3] : p[7], 32);
            float t0 = (u4 ? q2 : q0) + __shfl_xor(u4 ? q0 : q2, 16);
            float t1 = (u4 ? q3 : q1) + __shfl_xor(u4 ? q1 : q3, 16);
            float f = (u3 ? t1 : t0) + __shfl_xor(u3 ? t0 : t1, 8);
            f += __shfl_xor(f, 4); f += __shfl_xor(f, 2); f += __shfl_xor(f, 1);
            const int e = (lane >> 3) & 7;
            if ((lane & 7) == 0) { const float xg = f + F.b_forget[e]; const float t = -xg * LOG2E;
                const float lf = -(fmaxf(t, 0.f) + __builtin_amdgcn_logf(1.0f + __builtin_amdgcn_exp2f(-fabsf(t))));
                F.LOGF[(size_t)row * 8 + e] = lf; }
        }
    }
}

__device__ __forceinline__ void ph_scan(Frame& F) {
    const int gw = F.vcu * NWAVES + F.wave;
    if (gw >= BATCH * NH) return;
    const int b = gw >> 3, e = gw & 7, lane = F.lane, t0 = 32 * lane;
    float vals[32]; float run = 0.f;
#pragma unroll
    for (int i = 0; i < 32; ++i) { run += F.LOGF[((size_t)b * SEQ + t0 + i) * 8 + e]; vals[i] = run; }
    float incl = run;
#pragma unroll
    for (int o = 1; o < 64; o <<= 1) { const float n = __shfl_up(incl, o); if (lane >= o) incl += n; }
    const float off = incl - run;
#pragma unroll
    for (int i = 0; i < 32; ++i) F.F2[(size_t)gw * SEQ + t0 + i] = vals[i] + off;
}

typedef float f32x16 __attribute__((ext_vector_type(16)));
__device__ __forceinline__ int crow(int r, int hi) { return (r & 3) + 8 * (r >> 2) + 4 * hi; }
__device__ __forceinline__ bf16x8 pack8(const f32x16& p, int base) {
    v4u w; w.x = pg8::cvt_pk_bf16(p[base + 0], p[base + 1]); w.y = pg8::cvt_pk_bf16(p[base + 2], p[base + 3]); w.z = pg8::cvt_pk_bf16(p[base + 4], p[base + 5]); w.w = pg8::cvt_pk_bf16(p[base + 6], p[base + 7]);
    return __builtin_bit_cast(bf16x8, w);
}
#define MFMA32(a, b, c) __builtin_amdgcn_mfma_f32_32x32x16_bf16(a, b, c, 0, 0, 0)
template <int MODE>
__device__ __forceinline__ void attn_simple(Frame& F, int b, int h, int qblk) {
    const int lane = F.lane, r32 = lane & 31, hi = lane >> 5;
    const bf16* Qs = F.QKVZ + (size_t)(MODE * 4 + 0) * SEC_ELEMS; const bf16* Ks = F.QKVZ + (size_t)(MODE * 4 + 1) * SEC_ELEMS;
    const bf16* Vs = F.QKVZ + (size_t)(MODE * 4 + 2) * SEC_ELEMS; const bf16* Zs = F.QKVZ + (size_t)(MODE * 4 + 3) * SEC_ELEMS;
    const size_t rowb = (size_t)b * SEQ; const int qw0 = qblk * 32, t = qw0 + r32;
    bf16x8 qr[4];
#pragma unroll
    for (int d0 = 0; d0 < 4; ++d0) qr[d0] = *(const GAS bf16x8*)(Qs + (rowb + t) * DSEC + h * HD + d0 * 16 + hi * 8);
    f32x16 o[2]; o[0] = f32x16{}; o[1] = f32x16{};
    float carry = 0.f, mrun = -INFINITY, lsum = 0.f, Ft = 0.f;
    const float* F2row = F.F2 + (size_t)(b * NH + h) * SEQ;
    if (MODE == 1) Ft = F2row[t];
    bf16x8 ut0, ut1, ones;
    {   short a0[8], a1[8];
#pragma unroll
        for (int jj = 0; jj < 8; ++jj) { const int jk = 8 * (jj >> 2) + 4 * hi + (jj & 3); a0[jj] = (jk >= r32) ? (short)0x3F80 : (short)0; a1[jj] = (16 + jk >= r32) ? (short)0x3F80 : (short)0; }
        ut0 = (bf16x8){a0[0], a0[1], a0[2], a0[3], a0[4], a0[5], a0[6], a0[7]}; ut1 = (bf16x8){a1[0], a1[1], a1[2], a1[3], a1[4], a1[5], a1[6], a1[7]};
        ones = (bf16x8){(short)0x3F80, (short)0x3F80, (short)0x3F80, (short)0x3F80, (short)0x3F80, (short)0x3F80, (short)0x3F80, (short)0x3F80}; }
    const int jdiag = qw0 / 64;
    for (int jt = jdiag; jt >= 0; --jt) {
        const int kv0 = 64 * jt;
        f32x16 p0 = f32x16{}, p1 = f32x16{};
#pragma unroll
        for (int d0 = 0; d0 < 4; ++d0) {
            const bf16x8 k0 = *(const GAS bf16x8*)(Ks + (rowb + kv0 + r32) * DSEC + h * HD + d0 * 16 + hi * 8);
            const bf16x8 k1 = *(const GAS bf16x8*)(Ks + (rowb + kv0 + 32 + r32) * DSEC + h * HD + d0 * 16 + hi * 8);
            p0 = MFMA32(k0, qr[d0], p0); p1 = MFMA32(k1, qr[d0], p1); asm volatile("" ::: "memory"); }
        bf16x8 pa[4];
        if (MODE == 0) {
            f32x16 s0, s1;
#pragma unroll
            for (int r = 0; r < 16; ++r) { const int kv = kv0 + crow(r, hi);
                float z0 = fminf(p0[r], 126.f), z1 = fminf(p1[r], 126.f);
                float e0 = __builtin_amdgcn_logf(1.0f + __builtin_amdgcn_exp2f(z0)), e1 = __builtin_amdgcn_logf(1.0f + __builtin_amdgcn_exp2f(z1));
                if (jt == jdiag) { if (!(kv < t)) { e0 = 0.f; z0 = -INFINITY; } if (!(kv + 32 < t)) { e1 = 0.f; z1 = -INFINITY; } }
                s0[r] = e0; s1[r] = e1; p0[r] = z0; p1[r] = z1; }
            f32x16 cv;
#pragma unroll
            for (int r = 0; r < 16; ++r) cv[r] = carry;
            const bf16x8 l0 = pack8(s0, 0), l1 = pack8(s0, 8), l2 = pack8(s1, 0), l3 = pack8(s1, 8);
            f32x16 g0 = MFMA32(ut0, l0, cv); g0 = MFMA32(ut1, l1, g0); g0 = MFMA32(ones, l2, g0); g0 = MFMA32(ones, l3, g0);
            f32x16 g1 = MFMA32(ut0, l2, cv); g1 = MFMA32(ut1, l3, g1);
#pragma unroll
            for (int r = 0; r < 16; ++r) { p0[r] = __builtin_amdgcn_exp2f(p0[r] - g0[r]); p1[r] = __builtin_amdgcn_exp2f(p1[r] - g1[r]); }
            carry = __shfl(g0[0], r32);
        } else {
            float mx = -INFINITY;
#pragma unroll
            for (int r = 0; r < 16; ++r) { const int kv = kv0 + crow(r, hi);
                float z0 = p0[r] + (Ft - F2row[kv]), z1 = p1[r] + (Ft - F2row[kv + 32]);
                if (jt == jdiag) { if (kv > t) z0 = -INFINITY; if (kv + 32 > t) z1 = -INFINITY; }
                p0[r] = z0; p1[r] = z1; mx = fmaxf(mx, fmaxf(z0, z1)); }
            mx = fmaxf(mx, __shfl_xor(mx, 32));
            const float mnew = fmaxf(mrun, mx), alpha = __builtin_amdgcn_exp2f(mrun - mnew); mrun = mnew;
            float ps = 0.f;
#pragma unroll
            for (int r = 0; r < 16; ++r) { p0[r] = __builtin_amdgcn_exp2f(p0[r] - mnew); p1[r] = __builtin_amdgcn_exp2f(p1[r] - mnew); ps += p0[r] + p1[r]; }
            lsum = lsum * alpha + ps;
#pragma unroll
            for (int r = 0; r < 16; ++r) { const float ar = __shfl(alpha, crow(r, hi)); o[0][r] *= ar; o[1][r] *= ar; }
        }
        pa[0] = pack8(p0, 0); pa[1] = pack8(p0, 8); pa[2] = pack8(p1, 0); pa[3] = pack8(p1, 8);
#pragma unroll
        for (int d0 = 0; d0 < 2; ++d0)
#pragma unroll
            for (int s = 0; s < 4; ++s) { short vv[8];
#pragma unroll
                for (int jj = 0; jj < 8; ++jj) { const int kv = kv0 + 16 * s + 8 * (jj >> 2) + 4 * hi + (jj & 3); vv[jj] = (short)Vs[(rowb + kv) * DSEC + h * HD + 32 * d0 + r32]; }
                const bf16x8 vf = (bf16x8){vv[0], vv[1], vv[2], vv[3], vv[4], vv[5], vv[6], vv[7]};
                o[d0] = MFMA32(pa[s], vf, o[d0]); asm volatile("" ::: "memory"); }
        if (MODE == 0) { if (__all(carry > SB_STOP)) break; }
    }
    float inv = 1.f;
    if (MODE == 1) { const float lt = lsum + __shfl_xor(lsum, 32); inv = 1.0f / lt; }
#pragma unroll
    for (int r = 0; r < 16; ++r) { const int q = crow(r, hi); const float ir = (MODE == 1) ? __shfl(inv, q) : 1.f;
#pragma unroll
        for (int d0 = 0; d0 < 2; ++d0) { const size_t row = rowb + qw0 + q; const int col = h * HD + 32 * d0 + r32;
            const float zs = pg8::bf_lo((unsigned)Zs[row * DSEC + col]);
            F.HY[row * D + MODE * DSEC + col] = (bf16)f2bf(o[d0][r] * ir * zs); } }
}
__device__ __forceinline__ void ph_attn_simple(Frame& F) {
    const int gw = F.vcu * NWAVES + F.wave, NGW = F.G * NWAVES;
    for (int i = gw; i < 2 * BATCH * NH * (SEQ / 32); i += NGW) {
        const int qblk = (SEQ / 32 - 1) - (i >> 8), rest = i & 255, br = rest >> 7, bh = rest & 127;
        if (br == 0) attn_simple<0>(F, bh >> 3, bh & 7, qblk); else attn_simple<1>(F, bh >> 3, bh & 7, qblk);
    }
}

__device__ __forceinline__ void ph_norm(Frame& F) {
    const int gw = F.vcu * NWAVES + F.wave, NGW = F.G * NWAVES, lane = F.lane;
    f32x4 g[4];
#pragma unroll
    for (int j = 0; j < 4; ++j) g[j] = *(const GAS f32x4*)(F.final_g + 256 * j + 4 * lane);
    for (int row = gw; row < M; row += NGW) {
        GAS f32x4* xr = (GAS f32x4*)(F.out + (size_t)row * D) + lane;
        f32x4 v[4]; float s = 0.f;
#pragma unroll
        for (int j = 0; j < 4; ++j) { v[j] = xr[64 * j]; s += (v[j].x * v[j].x + v[j].y * v[j].y) + (v[j].z * v[j].z + v[j].w * v[j].w); }
        const float inv = 1.0f / sqrtf(wave_sum(s) * (1.0f / D) + RMS_EPS);
#pragma unroll
        for (int j = 0; j < 4; ++j) xr[64 * j] = (v[j] * inv) * g[j];
    }
}


struct Args { const float* in[12]; float* out; unsigned char* ws; int ph_lo, ph_hi, li, pad; };
constexpr int N_PHASES = 9;
__global__ void __launch_bounds__(NWAVES * 64, 2) mk_fwd(Args args) {
    extern __shared__ __attribute__((aligned(16))) unsigned char lds[];
    Frame F;
    F.lds = (LAS unsigned char*)lds;
    F.MISC = (volatile LAS unsigned*)(F.lds + MISC_OFF);
    F.tid = threadIdx.x; F.lane = F.tid & 63; F.wave = __builtin_amdgcn_readfirstlane(F.tid >> 6);
    F.G = gridDim.x; { const int bx = blockIdx.x; F.vcu = (F.G % 8 == 0) ? (bx % 8) * (F.G / 8) + bx / 8 : bx; }
    unsigned char* ws = args.ws;
    F.ctl = (gu32*)(ws + WS_CTL);
    F.x = args.in[0]; F.c = args.in[1]; F.w_ada = args.in[2]; F.b_ada = args.in[3]; F.norm_g = args.in[4]; F.w_in = args.in[5]; F.b_forget = args.in[6];
    F.w_o_sb = args.in[7]; F.w_o_fox = args.in[8]; F.b_gate = args.in[9]; F.w_out = args.in[10]; F.final_g = args.in[11]; F.out = args.out;
    F.MOD = (float*)(ws + WS_MOD); F.LOGF = (float*)(ws + WS_LOGF); F.F2 = (float*)(ws + WS_F2); F.WF = (float*)(ws + WS_WF);
    F.WIN_T = (bf16*)(ws + WS_WIN); F.WO_T = (bf16*)(ws + WS_WO); F.WOUT_T = (bf16*)(ws + WS_WOUT); F.HY = (bf16*)(ws + WS_HY);
    F.QKVZ = (bf16*)(ws + WS_QKVZ); F.GATES = (bf16*)(ws + WS_GATES); F.MERGED = (bf16*)(ws + WS_MERGED);
    const int lo = args.ph_lo, hi = args.ph_hi;
#ifndef PH_MASK
#define PH_MASK 0x1ff
#endif
#define IN(k) (((PH_MASK >> (k)) & 1) && lo <= (k) && (k) < hi)
    if (IN(0)) ph_p0a(F);
    if (IN(1)) ph_p0b(F);
    if (IN(2)) ph_scan(F);
    if (IN(3)) {
        pg8::Gemm g{F.HY, F.WIN_T, M, NPROJ, D, D, D}; pg8::StaticOrder S; S.init(M, NPROJ, F.G, (int)blockIdx.x);
        pg8::EpiProj E{F.QKVZ, SEC_ELEMS, F.GATES, F.b_gate, C2};
        pg8::gemm_phase<pg8::EpiProj, pg8::StaticOrder, true, true>(F.lds + RING_OFF, g, S, E);
    }
    if (IN(4)) ph_attn_simple(F);
    if (IN(5)) {
        pg8::Gemm g{F.HY, F.WO_T, M, D, DSEC, D, D}; pg8::StaticOrder S; S.init(M, D, F.G, (int)blockIdx.x);
        pg8::EpiGateF32 E{F.out, F.GATES, 0};
        pg8::gemm_phase<pg8::EpiGateF32, pg8::StaticOrder, true, true>(F.lds + RING_OFF, g, S, E);
    }
    if (IN(6)) {
        pg8::Gemm g{F.HY + DSEC, F.WO_T + DSEC, M, D, DSEC, D, D}; pg8::StaticOrder S; S.init(M, D, F.G, (int)blockIdx.x);
        pg8::EpiMerge E{F.out, F.GATES, 1024, F.MERGED};
        pg8::gemm_phase<pg8::EpiMerge, pg8::StaticOrder, true, true>(F.lds + RING_OFF, g, S, E);
    }
    if (IN(7)) {
        pg8::Gemm g{F.MERGED, F.WOUT_T, M, D, D, D, D}; pg8::StaticOrder S; S.init(M, D, F.G, (int)blockIdx.x);
        pg8::EpiResid E{F.x, F.MOD, F.out, SEQ};
        pg8::gemm_phase<pg8::EpiResid, pg8::StaticOrder, true, true>(F.lds + RING_OFF, g, S, E);
    }
    if (IN(8)) ph_norm(F);
#undef IN
}

extern "C" void kernel_launch(void* const* d_in, const int* in_sizes, int n_in, void* d_out, int out_size, void* d_ws, size_t ws_size, hipStream_t stream) {
    static int grid = 0;
    if (grid == 0) {
        if (n_in != 12 || in_sizes[0] != M * D || out_size != M * D || ws_size < WS_END) { fprintf(stderr, "kernel_launch: shape/workspace mismatch: n_in %d in0 %d out %d ws %zu (need %zu)\n", n_in, n_in > 0 ? in_sizes[0] : -1, out_size, ws_size, (size_t)WS_END); grid = -1; return; }
        int dev = 0, cus = 0, per_cu = 0;
        if (hipGetDevice(&dev) != hipSuccess || hipDeviceGetAttribute(&cus, hipDeviceAttributeMultiprocessorCount, dev) != hipSuccess) { grid = -1; return; }
        if (hipFuncSetAttribute((const void*)mk_fwd, hipFuncAttributeMaxDynamicSharedMemorySize, LDS_BYTES) != hipSuccess) { fprintf(stderr, "kernel_launch: hipFuncSetAttribute failed\n"); grid = -1; return; }
        if (hipOccupancyMaxActiveBlocksPerMultiprocessor(&per_cu, (const void*)mk_fwd, NWAVES * 64, LDS_BYTES) != hipSuccess || per_cu < 1) { fprintf(stderr, "kernel_launch: occupancy query says %d\n", per_cu); per_cu = 1; }
        (void)hipGetLastError();
        grid = cus * (per_cu < 1 ? 1 : 1);
    }
    if (grid < 0) return;
    (void)hipMemsetAsync((char*)d_ws + WS_CTL, 0, CTL_ZERO_BYTES, stream);
    Args a{};
    for (int i = 0; i < 12; ++i) a.in[i] = (const float*)d_in[i];
    a.out = (float*)d_out; a.ws = (unsigned char*)d_ws;
    for (int li = 0; li < N_PHASES; ++li) {
        a.ph_lo = li; a.ph_hi = li + 1; a.li = li;
        hipLaunchKernelGGL(mk_fwd, dim3(grid), dim3(NWAVES * 64), LDS_BYTES, stream, a);
    }
}
```

```cpp
#include <hip/hip_runtime.h>
#include <cstdio>
#include <cstdint>
#include <cmath>
namespace pg8 {
#define PG8_LAS __attribute__((address_space(3)))
typedef unsigned short bf16_t;
typedef short bf16x8 __attribute__((ext_vector_type(8)));
typedef float f32x4 __attribute__((ext_vector_type(4)));
typedef unsigned u32x4 __attribute__((ext_vector_type(4)));
constexpr int BM = 256, BK = 64, HALF = 128, HTB = HALF * BK * 2  , STAGE_BYTES = 8 * HTB, NXCD = 8, WGM = 8;

__host__ __device__ __forceinline__ int lds_byte(int r, int c) { const int st = (r >> 4) * 2 + (c >> 5), rr = r & 15, cc = c & 31, ob = rr * 64 + cc * 2; return st * 1024 + (ob ^ (((ob >> 9) & 1) << 5)); }
__host__ __device__ __forceinline__ void stage_rc(int b, int& R, int& C) { const int st = b / 1024, sb = b % 1024, swz = sb ^ (((sb >> 9) & 1) << 5); R = (st >> 1) * 16 + swz / 64; C = (st & 1) * 32 + (swz % 64) / 2; }
__host__ __device__ __forceinline__ int perm32(int rho) { const int n = rho >> 4, i = rho & 15; return 8 * (i >> 2) + 4 * n + (i & 3); }

struct Unit { int pm, pn; };
struct Gemm { const bf16_t* A; const bf16_t* Bt; int M, N, K, lda, ldb; };

struct StaticOrder {
    int nM, nN, nwg, G, c;
    __host__ __device__ void init(int M, int N, int G_, int c_) { nM = M / BM; nN = N / BM; nwg = nM * nN; G = G_; c = c_; }
    __host__ __device__ bool next(int i, Unit& u) const {
        const long L = (long)i * G + c; if (L >= nwg) return false;
        int wgid = (int)L; { const int q = nwg / NXCD, r = nwg % NXCD, xcd = wgid % NXCD, off = wgid / NXCD; wgid = (xcd < r ? xcd * (q + 1) : r * (q + 1) + (xcd - r) * q) + off; }
        const int nig = WGM * nN, gid = wgid / nig, fm = gid * WGM, gsz = (nM - fm) < WGM ? (nM - fm) : WGM;
        u.pm = fm + ((wgid % nig) % gsz); u.pn = (wgid % nig) / gsz; return true;
    }
    __device__ __forceinline__ void a_ready(const Unit&) const {}
    __device__ __forceinline__ void done(const Unit&) const {}
};


__device__ __forceinline__ unsigned cvt_pk_bf16(float lo, float hi) { unsigned r; asm volatile("v_cvt_pk_bf16_f32 %0, %1, %2" : "=v"(r) : "v"(lo), "v"(hi)); return r; }
__device__ __forceinline__ float bf_lo(unsigned w) { return __builtin_bit_cast(float, w << 16); }
__device__ __forceinline__ float bf_hi(unsigned w) { return __builtin_bit_cast(float, w & 0xffff0000u); }
__device__ __forceinline__ float sigmoid_f(float v) { return __builtin_amdgcn_rcpf(1.0f + __builtin_amdgcn_exp2f(-1.4426950408889634f * v)); }

struct EpiProj {
    static constexpr bool PERM = true, AFTER_DRAIN = false;
    bf16_t* QKVZ; size_t sec_stride; bf16_t* GATES; const float* b_gate; float qscale;
    __device__ __forceinline__ void operator()(const f32x4 (&acc)[2][2][4][2], const Unit& u, int wr, int wc, int fr, int fq) const {
        const int sec = u.pn >> 1; const int row0 = u.pm * BM + wr * 64 + fr;
        bf16_t* base; int ldc, col0; int mode; float sc = 1.f;
        if (sec < 8) { base = QKVZ + (size_t)sec * sec_stride; ldc = 512; col0 = (u.pn & 1) * 256 + wc * 32 + 8 * fq; mode = ((sec & 3) == 3) ? 1 : 0; if ((sec & 3) == 0) sc = qscale; }
        else { base = GATES; ldc = 2048; col0 = (u.pn - 16) * 256 + wc * 32 + 8 * fq; mode = 2; }
        f32x4 bv[2][2];
#pragma unroll
        for (int bj = 0; bj < 2; ++bj)
#pragma unroll
            for (int n = 0; n < 2; ++n) bv[bj][n] = (mode == 2) ? *(const f32x4*)(b_gate + col0 + bj * HALF + 4 * n) : (f32x4){0.f, 0.f, 0.f, 0.f};
#pragma unroll
        for (int ai = 0; ai < 2; ++ai)
#pragma unroll
            for (int m = 0; m < 4; ++m) { bf16_t* rowp = base + (size_t)(row0 + ai * HALF + m * 16) * ldc + col0;
#pragma unroll
                for (int bj = 0; bj < 2; ++bj) { f32x4 v0 = acc[ai][bj][m][0] + bv[bj][0], v1 = acc[ai][bj][m][1] + bv[bj][1];
                    if (mode != 0) {
#pragma unroll
                        for (int e = 0; e < 4; ++e) { const float s0 = sigmoid_f(v0[e]), s1 = sigmoid_f(v1[e]); v0[e] = (mode == 2) ? s0 : v0[e] * s0; v1[e] = (mode == 2) ? s1 : v1[e] * s1; } }
                    v0 = v0 * sc; v1 = v1 * sc; u32x4 w; w.x = cvt_pk_bf16(v0[0], v0[1]); w.y = cvt_pk_bf16(v0[2], v0[3]); w.z = cvt_pk_bf16(v1[0], v1[1]); w.w = cvt_pk_bf16(v1[2], v1[3]);
                    *(u32x4*)(rowp + bj * HALF) = w; } }
    }
};
struct EpiGateF32 {
    static constexpr bool PERM = false, AFTER_DRAIN = false;
    float* T; const bf16_t* G; int goff;
    __device__ __forceinline__ void operator()(const f32x4 (&acc)[2][2][4][2], const Unit& u, int wr, int wc, int fr, int fq) const {
        const int row0 = u.pm * BM + wr * 64 + fr, col0 = u.pn * BM + wc * 32 + 4 * fq;
#pragma unroll
        for (int ai = 0; ai < 2; ++ai)
#pragma unroll
            for (int m = 0; m < 4; ++m) { const size_t r = (size_t)(row0 + ai * HALF + m * 16);
#pragma unroll
                for (int bj = 0; bj < 2; ++bj)
#pragma unroll
                    for (int n = 0; n < 2; ++n) { const int c = col0 + bj * HALF + n * 16; const uint2 gw = *(const uint2*)(G + r * 2048 + goff + c);
                        f32x4 v = acc[ai][bj][m][n]; v[0] *= bf_lo(gw.x); v[1] *= bf_hi(gw.x); v[2] *= bf_lo(gw.y); v[3] *= bf_hi(gw.y);
                        *(f32x4*)(T + r * 1024 + c) = v; } }
    }
};
struct EpiMerge {
    static constexpr bool PERM = true, AFTER_DRAIN = false;
    const float* T; const bf16_t* G; int goff; bf16_t* O;
    __device__ __forceinline__ void operator()(const f32x4 (&acc)[2][2][4][2], const Unit& u, int wr, int wc, int fr, int fq) const {
        const int row0 = u.pm * BM + wr * 64 + fr, col0 = u.pn * BM + wc * 32 + 8 * fq;
#pragma unroll
        for (int ai = 0; ai < 2; ++ai)
#pragma unroll
            for (int m = 0; m < 4; ++m) { const size_t r = (size_t)(row0 + ai * HALF + m * 16);
#pragma unroll
                for (int bj = 0; bj < 2; ++bj) { const int c = col0 + bj * HALF; const u32x4 gw = *(const u32x4*)(G + r * 2048 + goff + c);
                    const f32x4 t0 = *(const f32x4*)(T + r * 1024 + c), t1 = *(const f32x4*)(T + r * 1024 + c + 4);
                    f32x4 v0 = acc[ai][bj][m][0], v1 = acc[ai][bj][m][1];
                    v0[0] = t0[0] + v0[0] * bf_lo(gw.x); v0[1] = t0[1] + v0[1] * bf_hi(gw.x); v0[2] = t0[2] + v0[2] * bf_lo(gw.y); v0[3] = t0[3] + v0[3] * bf_hi(gw.y);
                    v1[0] = t1[0] + v1[0] * bf_lo(gw.z); v1[1] = t1[1] + v1[1] * bf_hi(gw.z); v1[2] = t1[2] + v1[2] * bf_lo(gw.w); v1[3] = t1[3] + v1[3] * bf_hi(gw.w);
                    u32x4 w; w.x = cvt_pk_bf16(v0[0], v0[1]); w.y = cvt_pk_bf16(v0[2], v0[3]); w.z = cvt_pk_bf16(v1[0], v1[1]); w.w = cvt_pk_bf16(v1[2], v1[3]);
                    *(u32x4*)(O + r * 1024 + c) = w; } }
    }
};
struct EpiResid {
    static constexpr bool PERM = false, AFTER_DRAIN = false;
    const float* X; const float* MOD; float* O; int rows_per_b;
    __device__ __forceinline__ void operator()(const f32x4 (&acc)[2][2][4][2], const Unit& u, int wr, int wc, int fr, int fq) const {
        const int row0 = u.pm * BM + wr * 64 + fr, col0 = u.pn * BM + wc * 32 + 4 * fq;
        const int b = (u.pm * BM) / rows_per_b;
        f32x4 gv[2][2];
#pragma unroll
        for (int bj = 0; bj < 2; ++bj)
#pragma unroll
            for (int n = 0; n < 2; ++n) gv[bj][n] = *(const f32x4*)(MOD + (size_t)b * 3072 + 2048 + col0 + bj * HALF + n * 16);
#pragma unroll
        for (int ai = 0; ai < 2; ++ai)
#pragma unroll
            for (int m = 0; m < 4; ++m) { const size_t r = (size_t)(row0 + ai * HALF + m * 16);
#pragma unroll
                for (int bj = 0; bj < 2; ++bj)
#pragma unroll
                    for (int n = 0; n < 2; ++n) { const int c = col0 + bj * HALF + n * 16; const f32x4 xv = *(const f32x4*)(X + r * 1024 + c);
                        *(f32x4*)(O + r * 1024 + c) = xv + gv[bj][n] * acc[ai][bj][m][n]; } }
    }
};

template <class Epi, class Sched, bool ALIGN_EPI = false, bool SP2 = false>
__device__ __forceinline__ void gemm_phase(PG8_LAS unsigned char* lds, const Gemm g, const Sched& S, const Epi& E) {
    const int tid = threadIdx.x, wid = __builtin_amdgcn_readfirstlane(tid >> 6), lane = tid & 63, wr = wid >> 2, wc = wid & 3, fr = lane & 15, fq = lane >> 4;
    const int K = g.K, nt = K / BK;
    unsigned voffA[2], voffB[2];
#pragma unroll
    for (int i = 0; i < 2; ++i) { int R, C; stage_rc(tid * 16 + i * 8192, R, C); const int Rb = Epi::PERM ? ((R & ~31) + perm32(R & 31)) : R;
        voffA[i] = (unsigned)(R * g.lda + C) * 2u; voffB[i] = (unsigned)(Rb * g.ldb + C) * 2u; }
    const size_t kstep = (size_t)(BK * 2);
    const size_t hstepA = (size_t)HALF * g.lda * 2, hstepB = (size_t)HALF * g.ldb * 2;
    const size_t tstepA = 2 * hstepA, tstepB = 2 * hstepB;
    const unsigned ldsw = (unsigned)wid * 1024u;
    const int aoff = lds_byte(wr * 64 + fr, fq * 8), boff = lds_byte(wc * 32 + fr, fq * 8);
#define PG8_SA(b, h) (((b) * 2 + (h)) * HTB)
#define PG8_SB(b, h) ((4 + (b) * 2 + (h)) * HTB)
#define PG8_STAGE(bufoff, gbase, voff) do { _Pragma("unroll") for (int _i = 0; _i < 2; ++_i) \
        __builtin_amdgcn_global_load_lds((const unsigned*)((const char*)(gbase) + (voff)[_i]), (PG8_LAS unsigned*)(lds + (bufoff) + ldsw + _i * 8192), 16, 0, 0); } while (0)
#define PG8_LDA(dst, b, h) do { _Pragma("unroll") for (int m = 0; m < 4; ++m) _Pragma("unroll") for (int k = 0; k < 2; ++k) dst[m][k] = *(const PG8_LAS bf16x8*)(lds + PG8_SA(b, h) + aoff + m * 2048 + k * 1024); } while (0)
#define PG8_LDB(dst, b, h) do { _Pragma("unroll") for (int n = 0; n < 2; ++n) _Pragma("unroll") for (int k = 0; k < 2; ++k) dst[n][k] = *(const PG8_LAS bf16x8*)(lds + PG8_SB(b, h) + boff + n * 2048 + k * 1024); } while (0)
#define PG8_MMA(ai, bj, At, Bt) do { __builtin_amdgcn_s_setprio(1); _Pragma("unroll") for (int m = 0; m < 4; ++m) _Pragma("unroll") for (int n = 0; n < 2; ++n) _Pragma("unroll") for (int k = 0; k < 2; ++k) \
        acc[ai][bj][m][n] = __builtin_amdgcn_mfma_f32_16x16x32_bf16(Bt[n][k], At[m][k], acc[ai][bj][m][n], 0, 0, 0); __builtin_amdgcn_s_setprio(0); } while (0)
#define PG8_WAIT_V(n) asm volatile("s_waitcnt vmcnt(" #n ")" ::: "memory")
#define PG8_WAIT_L(n) asm volatile("s_waitcnt lgkmcnt(" #n ")" ::: "memory")
#define PG8_BAR __builtin_amdgcn_s_barrier()
#define PG8_SCHED __builtin_amdgcn_sched_barrier(0)
    Unit cur, nxt; int ui = 0;
    if (!S.next(0, cur)) return;
    f32x4 acc[2][2][4][2];
#pragma unroll
    for (int a = 0; a < 2; ++a)
#pragma unroll
        for (int b = 0; b < 2; ++b)
#pragma unroll
            for (int m = 0; m < 4; ++m)
#pragma unroll
                for (int n = 0; n < 2; ++n) acc[a][b][m][n] = (f32x4){0.f, 0.f, 0.f, 0.f};
    bf16x8 At[4][2], B0[2][2], B1[2][2];
    const char* cA = (const char*)g.A + (size_t)cur.pm * tstepA; const char* cB = (const char*)g.Bt + (size_t)cur.pn * tstepB;
    S.a_ready(cur);
    if constexpr (SP2) {
        PG8_STAGE(PG8_SB(0, 0), cB, voffB); PG8_STAGE(PG8_SB(0, 1), cB + hstepB, voffB); PG8_STAGE(PG8_SA(0, 0), cA, voffA); PG8_STAGE(PG8_SA(0, 1), cA + hstepA, voffA);
        if (wr == 1) PG8_BAR;
        PG8_WAIT_V(2); PG8_BAR;
        PG8_STAGE(PG8_SB(1, 0), cB + kstep, voffB); PG8_STAGE(PG8_SA(1, 0), cA + kstep, voffA); PG8_STAGE(PG8_SB(1, 1), cB + hstepB + kstep, voffB);
        PG8_WAIT_V(6); PG8_BAR;
    } else {
        PG8_STAGE(PG8_SB(0, 0), cB, voffB); PG8_STAGE(PG8_SA(0, 0), cA, voffA); PG8_STAGE(PG8_SB(0, 1), cB + hstepB, voffB); PG8_STAGE(PG8_SA(0, 1), cA + hstepA, voffA);
        if (wr == 1) PG8_BAR;
        PG8_WAIT_V(4); PG8_BAR;
        PG8_STAGE(PG8_SB(1, 0), cB + kstep, voffB); PG8_STAGE(PG8_SA(1, 0), cA + kstep, voffA); PG8_STAGE(PG8_SB(1, 1), cB + hstepB + kstep, voffB);
        PG8_WAIT_V(6); PG8_BAR;
    }
    for (;;) {
        const bool has_next = S.next(ui + 1, nxt);
        const char* nA = has_next ? (const char*)g.A + (size_t)nxt.pm * tstepA : cA; const char* nB = has_next ? (const char*)g.Bt + (size_t)nxt.pn * tstepB : cB;
        for (int t = 0; t < nt; t += 2) {
            const bool last = (t == nt - 2);
            const char* a1 = cA + (size_t)(t + 1) * kstep;
            const char* a2 = last ? nA : cA + (size_t)(t + 2) * kstep; const char* b2 = last ? nB : cB + (size_t)(t + 2) * kstep;
            const char* a3 = a2 + kstep; const char* b3 = b2 + kstep;
            if (last && has_next) S.a_ready(nxt);
            if constexpr (SP2) {
            PG8_LDB(B0, 0, 0); PG8_LDB(B1, 0, 1); PG8_SCHED; PG8_LDA(At, 0, 0); PG8_STAGE(PG8_SA(1, 1), a1 + hstepA, voffA);
            PG8_WAIT_V(8); PG8_WAIT_L(0); PG8_BAR; PG8_MMA(0, 0, At, B0); PG8_MMA(0, 1, At, B1); PG8_BAR; PG8_SCHED;
            PG8_LDA(At, 0, 1); PG8_STAGE(PG8_SB(0, 0), b2, voffB); PG8_STAGE(PG8_SB(0, 1), b2 + hstepB, voffB); PG8_STAGE(PG8_SA(0, 0), a2, voffA);
            PG8_WAIT_V(8); PG8_WAIT_L(0); PG8_BAR; PG8_MMA(1, 0, At, B0); PG8_MMA(1, 1, At, B1); PG8_BAR; PG8_SCHED;
            PG8_LDB(B0, 1, 0); PG8_LDB(B1, 1, 1); PG8_SCHED; PG8_LDA(At, 1, 0); PG8_STAGE(PG8_SA(0, 1), a2 + hstepA, voffA);
            PG8_WAIT_V(8); PG8_WAIT_L(0); PG8_BAR; PG8_MMA(0, 0, At, B0); PG8_MMA(0, 1, At, B1); PG8_BAR; PG8_SCHED;
            PG8_LDA(At, 1, 1); PG8_STAGE(PG8_SB(1, 0), b3, voffB); PG8_STAGE(PG8_SB(1, 1), b3 + hstepB, voffB); PG8_STAGE(PG8_SA(1, 0), a3, voffA);
            PG8_WAIT_V(8); PG8_WAIT_L(0); PG8_BAR; PG8_MMA(1, 0, At, B0); PG8_MMA(1, 1, At, B1); PG8_BAR; PG8_SCHED;
            } else {
            PG8_LDB(B0, 0, 0); PG8_SCHED; PG8_LDA(At, 0, 0); PG8_STAGE(PG8_SA(1, 1), a1 + hstepA, voffA);
            PG8_WAIT_L(8); PG8_BAR; PG8_WAIT_L(0); PG8_MMA(0, 0, At, B0); PG8_BAR; PG8_SCHED;
            PG8_LDB(B1, 0, 1); PG8_STAGE(PG8_SB(0, 0), b2, voffB);
            PG8_BAR; PG8_WAIT_L(0); PG8_MMA(0, 1, At, B1); PG8_BAR;
            PG8_LDA(At, 0, 1); PG8_STAGE(PG8_SA(0, 0), a2, voffA);
            PG8_BAR; PG8_WAIT_L(0); PG8_MMA(1, 0, At, B0); PG8_BAR; PG8_SCHED;
            PG8_STAGE(PG8_SB(0, 1), b2 + hstepB, voffB);
            PG8_WAIT_V(6); PG8_BAR; PG8_MMA(1, 1, At, B1); PG8_BAR;
            PG8_LDB(B0, 1, 0); PG8_SCHED; PG8_LDA(At, 1, 0); PG8_STAGE(PG8_SA(0, 1), a2 + hstepA, voffA);
            PG8_WAIT_L(8); PG8_BAR; PG8_WAIT_L(0); PG8_MMA(0, 0, At, B0); PG8_BAR; PG8_SCHED;
            PG8_LDB(B1, 1, 1); PG8_STAGE(PG8_SB(1, 0), b3, voffB);
            PG8_BAR; PG8_WAIT_L(0); PG8_MMA(0, 1, At, B1); PG8_BAR;
            PG8_LDA(At, 1, 1); PG8_STAGE(PG8_SA(1, 0), a3, voffA);
            PG8_BAR; PG8_WAIT_L(0); PG8_MMA(1, 0, At, B0); PG8_BAR; PG8_SCHED;
            PG8_STAGE(PG8_SB(1, 1), b3 + hstepB, voffB);
            PG8_WAIT_V(6); PG8_BAR; PG8_MMA(1, 1, At, B1); PG8_BAR;
            }
        }
        if constexpr (ALIGN_EPI) { if (wr == 0) PG8_BAR; }
        if constexpr (!Epi::AFTER_DRAIN) { E(acc, cur, wr, wc, fr, fq); S.done(cur); }
        if (!has_next) break;
#pragma unroll
        for (int a = 0; a < 2; ++a)
#pragma unroll
            for (int b = 0; b < 2; ++b)
#pragma unroll
                for (int m = 0; m < 4; ++m)
#pragma unroll
                    for (int n = 0; n < 2; ++n) acc[a][b][m][n] = (f32x4){0.f, 0.f, 0.f, 0.f};
        cur = nxt; cA = nA; cB = nB; ++ui;
        if constexpr (ALIGN_EPI) { if (wr == 1) PG8_BAR; }
    }
    PG8_WAIT_V(0);
    if constexpr (!ALIGN_EPI) { if (wr == 0) PG8_BAR; }
    PG8_BAR;
    if constexpr (Epi::AFTER_DRAIN) { E.fused(acc, cur, wr, wc, fr, fq, lds, wid, lane); S.done(cur); }
#undef PG8_SA
#undef PG8_SB
#undef PG8_STAGE
#undef PG8_LDA
#undef PG8_LDB
#undef PG8_MMA
#undef PG8_WAIT_V
#undef PG8_WAIT_L
#undef PG8_BAR
#undef PG8_SCHED
}
}

#define GAS __attribute__((address_space(1)))
#define LAS __attribute__((address_space(3)))
typedef unsigned short bf16;
typedef unsigned v4u __attribute__((ext_vector_type(4)));
typedef float f32x4 __attribute__((ext_vector_type(4)));
typedef short bf16x8 __attribute__((ext_vector_type(8)));
typedef GAS unsigned gu32;
typedef GAS unsigned long long gu64;
#define RLX_AGENT __ATOMIC_RELAXED, __HIP_MEMORY_SCOPE_AGENT
#define LDS_WAIT() asm volatile("s_waitcnt lgkmcnt(0)" ::: "memory")
#define VM_WAIT() asm volatile("s_waitcnt vmcnt(0)" ::: "memory")
__device__ __forceinline__ unsigned long long rt() { return __builtin_amdgcn_s_memrealtime(); }
__device__ __forceinline__ unsigned f2bf(float f) { unsigned u = __builtin_bit_cast(unsigned, f); return (u + 0x7fffu + ((u >> 16) & 1u)) >> 16; }
__device__ __forceinline__ unsigned pk2(float lo, float hi) { return f2bf(lo) | (f2bf(hi) << 16); }

#define XB_TMO      128
#define XB_XCNT(j)  (256  + 64 * (j))
#define XB_XSUB(j)  (1280 + 64 * (j))
#define XB_XGEN(j)  (2304 + 64 * (j))
#define XB_TOP      3328
#define XB_TOPGEN   3392
#define XCD_BAR_WORDS 3456
#define XB_SPIN_CAP (1u << 18)

__device__ __forceinline__ unsigned xb_ld(unsigned* p)              { return __hip_atomic_load(p, __ATOMIC_RELAXED, __HIP_MEMORY_SCOPE_AGENT); }
__device__ __forceinline__ unsigned xb_add(unsigned* p, unsigned v) { return __hip_atomic_fetch_add(p, v, __ATOMIC_RELAXED, __HIP_MEMORY_SCOPE_AGENT); }
__device__ __forceinline__ unsigned xb_xcc_id() { return (unsigned)__builtin_amdgcn_s_getreg((3 << 11) | 20) & 0xFu; }
#define XB_SPIN(cond, bar) do { unsigned _sp = 0; while (cond) { __builtin_amdgcn_s_sleep(1); \
    if ((++_sp & 255u) == 0u) { if (xb_ld(&(bar)[XB_TMO])) break; if (_sp > XB_SPIN_CAP) { atomicAdd(&(bar)[XB_TMO], 1u); break; } } } } while (0)

struct XcdBarrier {
    unsigned* bar; unsigned x;
    volatile LAS unsigned* st;
};

__device__ __forceinline__ XcdBarrier xcd_barrier_post(unsigned* bar, volatile LAS unsigned* st) {
    XcdBarrier b; b.bar = bar; b.x = xb_xcc_id(); b.st = st;
    if (threadIdx.x == 0) (void)xb_add(&bar[XB_XCNT(b.x)], 1u);
    return b;
}
__device__ __forceinline__ void xcd_barrier_complete(unsigned* bar, unsigned x, unsigned& nloc, unsigned& nx) {
    const unsigned G = gridDim.x * gridDim.y * gridDim.z;
    unsigned sum, cnt, mine, sp = 0u;
    for (;;) {
        sum = 0u; cnt = 0u; mine = 0u;
#pragma unroll
        for (unsigned j = 0; j < 16; ++j) { const unsigned c = xb_ld(&bar[XB_XCNT(j)]); sum += c; cnt += (c > 0u) ? 1u : 0u; mine = (j == x) ? c : mine; }
        if (sum == G) break;
        __builtin_amdgcn_s_sleep(1);
        if ((++sp & 255u) == 0u) { if (xb_ld(&bar[XB_TMO])) break; if (sp > XB_SPIN_CAP) { atomicAdd(&bar[XB_TMO], 1u); break; } }
    }
    nloc = mine > 0u ? mine : 1u; nx = cnt > 0u ? cnt : 1u;
}

__device__ __forceinline__ void xcd_barrier(const XcdBarrier& b) {
    asm volatile("s_waitcnt vmcnt(0)" ::: "memory");
    __syncthreads();
    if (threadIdx.x == 0) {
        unsigned* bar = b.bar;
        __builtin_amdgcn_s_waitcnt(0);
        unsigned nloc = b.st[0], nx = b.st[1];
        if (nloc == 0u) { xcd_barrier_complete(bar, b.x, nloc, nx); b.st[0] = nloc; b.st[1] = nx; }
        const unsigned old = xb_add(&bar[XB_XSUB(b.x)], 1u);
        const unsigned gen = old / nloc;
        if (old + 1u == (gen + 1u) * nloc) {
            __builtin_amdgcn_fence(__ATOMIC_RELEASE, "agent");
            asm volatile("s_waitcnt vmcnt(0)" ::: "memory");
            const unsigned og = xb_add(&bar[XB_TOP], 1u);
            const unsigned tg = og / nx;
            if (og + 1u == (tg + 1u) * nx) xb_add(&bar[XB_TOPGEN], 1u);
            else XB_SPIN(xb_ld(&bar[XB_TOPGEN]) == tg, bar);
            __builtin_amdgcn_fence(__ATOMIC_ACQUIRE, "agent");
            xb_add(&bar[XB_XGEN(b.x)], 1u);
            asm volatile("s_waitcnt vmcnt(0)" ::: "memory");
        } else {
            XB_SPIN(xb_ld(&bar[XB_XGEN(b.x)]) == gen, bar);
            __builtin_amdgcn_fence(__ATOMIC_ACQUIRE, "agent");
            asm volatile("s_waitcnt vmcnt(0)" ::: "memory");
        }
    }
    __syncthreads();
}


constexpr int NWAVES = 8;
constexpr int BATCH = 16, SEQ = 2048, D = 1024, M = BATCH * SEQ, NH = 8, HD = 64, DSEC = 512;
constexpr int DIN = 6152, NPROJ = 6144, NGATE = 2048;
constexpr float RMS_EPS = 1e-6f;
constexpr float LOG2E = 1.4426950408889634f;
constexpr float C2 = 0.125f * LOG2E;
constexpr float SB_STOP = 64.0f;

constexpr size_t MiB = 1u << 20;
constexpr size_t WS_CTL = 0, CTL_ZERO_BYTES = 1 * MiB;
constexpr size_t WS_MOD = 1 * MiB;
constexpr size_t WS_LOGF = 2 * MiB;
constexpr size_t WS_F2 = 3 * MiB;
constexpr size_t WS_WIN = 4 * MiB;
constexpr size_t WS_WO = 16 * MiB;
constexpr size_t WS_WOUT = 18 * MiB;
constexpr size_t WS_WF = 20 * MiB;
constexpr size_t WS_HY = 32 * MiB;
constexpr size_t WS_QKVZ = 96 * MiB;
constexpr size_t SEC_ELEMS = (size_t)M * DSEC;
constexpr size_t WS_GATES = 352 * MiB;
constexpr size_t WS_MERGED = WS_QKVZ;
constexpr size_t WS_END = 480 * MiB;

constexpr int CW_BAR = 4096;

constexpr int RING_OFF = 0, RING_BYTES = 131072;
constexpr int LDSCTL_OFF = RING_BYTES, MISC_OFF = LDSCTL_OFF + 320;
constexpr int LDS_BYTES = 147456;

struct Frame {
    LAS unsigned char* lds;
    volatile LAS unsigned* MISC;
    gu32* ctl;
    int tid, lane, wave;
    int vcu, G;
    const float *x, *c, *w_ada, *b_ada, *norm_g, *w_in, *b_forget, *w_o_sb, *w_o_fox, *b_gate, *w_out, *final_g;
    float* out;
    float *MOD, *LOGF, *F2, *WF;
    bf16 *WIN_T, *WO_T, *WOUT_T, *HY, *QKVZ, *GATES, *MERGED;
};

__device__ __forceinline__ float wave_sum(float v) {
#pragma unroll
    for (int o = 1; o < 64; o <<= 1) v += __shfl_xor(v, o);
    return v;
}

__device__ __forceinline__ void transpose_item(const float* W, int ldw, int src_col0, bf16* WT, int ldt, int dst_row0, int dst_col0, LAS float* scr, int kb, int nb, int lane) {
    const int k0 = 64 * kb, n0 = 32 * nb;
#pragma unroll 8
    for (int i = 0; i < 32; ++i) { const int kk = 2 * i + (lane >> 5); scr[kk * 33 + (lane & 31)] = W[(size_t)(k0 + kk) * ldw + src_col0 + n0 + (lane & 31)]; }
    LDS_WAIT(); asm volatile("" ::: "memory");
    const int c = lane & 7;
#pragma unroll
    for (int j = 0; j < 4; ++j) { const int n = (lane >> 3) + 8 * j; const LAS float* s = scr + (8 * c) * 33 + n;
        v4u o; o.x = pk2(s[0 * 33], s[1 * 33]); o.y = pk2(s[2 * 33], s[3 * 33]); o.z = pk2(s[4 * 33], s[5 * 33]); o.w = pk2(s[6 * 33], s[7 * 33]);
        *(GAS v4u*)(WT + (size_t)(dst_row0 + n0 + n) * ldt + dst_col0 + k0 + 8 * c) = o; }
    LDS_WAIT(); asm volatile("" ::: "memory");
}
__device__ __forceinline__ void ph_p0a(Frame& F) {
    if (blockIdx.x < 96) {
        LAS float* cl = (LAS float*)(F.lds + RING_OFF);
        for (int i = F.tid; i < 16 * 1024 / 4; i += NWAVES * 64) ((LAS f32x4*)cl)[i] = ((const GAS f32x4*)F.c)[i];
        __syncthreads();
        const int col = F.tid & 31, ks = F.tid >> 5, j = blockIdx.x * 32 + col;
        float acc[16];
#pragma unroll
        for (int b = 0; b < 16; ++b) acc[b] = 0.f;
#pragma unroll 4
        for (int i = 0; i < 64; ++i) { const int k = ks * 64 + i; const float w = F.w_ada[(size_t)k * 3072 + j];
#pragma unroll
            for (int b = 0; b < 16; ++b) acc[b] += cl[b * 1024 + k] * w; }
        LAS float* red = cl + 16384;
#pragma unroll
        for (int b = 0; b < 16; ++b) red[(ks * 16 + b) * 32 + col] = acc[b];
        __syncthreads();
        { const int b = F.tid >> 5; float s = 0.f;
#pragma unroll
          for (int k2 = 0; k2 < 16; ++k2) s += red[(k2 * 16 + b) * 32 + col];
          F.MOD[b * 3072 + j] = s + F.b_ada[j]; }
        __syncthreads();
    }
    { const int g = blockIdx.x * (NWAVES * 64) + F.tid; if (g < 8192) { const int e = g >> 10, k = g & 1023; F.WF[g] = F.w_in[(size_t)k * DIN + 4096 + e]; } }
    LAS float* scr = (LAS float*)(F.lds + RING_OFF + F.wave * 16384);
    const int gw = F.vcu * NWAVES + F.wave, NGW = F.G * NWAVES;
    constexpr int I_A = 16 * 128, I_B = 16 * 64, I_O = 8 * 32, I_W = 16 * 32;
    constexpr int NITEMS = I_A + I_B + 2 * I_O + I_W;
    for (int it = gw; it < NITEMS; it += NGW) {
        int r = it;
        if (r < I_A) { transpose_item(F.w_in, DIN, 0, F.WIN_T, 1024, 0, 0, scr, r / 128, r % 128, F.lane); continue; } r -= I_A;
        if (r < I_B) { transpose_item(F.w_in, DIN, 4104, F.WIN_T, 1024, 4096, 0, scr, r / 64, r % 64, F.lane); continue; } r -= I_B;
        if (r < I_O) { transpose_item(F.w_o_sb, 1024, 0, F.WO_T, 1024, 0, 0, scr, r / 32, r % 32, F.lane); continue; } r -= I_O;
        if (r < I_O) { transpose_item(F.w_o_fox, 1024, 0, F.WO_T, 1024, 0, 512, scr, r / 32, r % 32, F.lane); continue; } r -= I_O;
        transpose_item(F.w_out, 1024, 0, F.WOUT_T, 1024, 0, 0, scr, r / 32, r % 32, F.lane);
    }
}

__device__ __forceinline__ void ph_p0b(Frame& F) {
    LAS float* wf = (LAS float*)(F.lds + RING_OFF);
    for (int i = F.tid; i < 8192 / 4; i += NWAVES * 64) ((LAS f32x4*)wf)[i] = ((const GAS f32x4*)F.WF)[i];
    __syncthreads();
    const int gw = F.vcu * NWAVES + F.wave, NGW = F.G * NWAVES;
    const int lane = F.lane;
    for (int blk = gw; blk < M / 16; blk += NGW) {
        const int row0 = blk * 16, b = row0 / SEQ;
        f32x4 ga[4], sh[4];
#pragma unroll
        for (int j = 0; j < 4; ++j) { const int col = 256 * j + 4 * lane;
            const f32x4 g = *(const GAS f32x4*)(F.norm_g + col), sc = *(const GAS f32x4*)(F.MOD + b * 3072 + 1024 + col);
            ga[j] = g * (1.0f + sc); sh[j] = *(const GAS f32x4*)(F.MOD + b * 3072 + col); }
        for (int r = 0; r < 16; ++r) {
            const int row = row0 + r;
            const GAS f32x4* xr = (const GAS f32x4*)(F.x + (size_t)row * D) + lane;
            f32x4 v[4]; float s = 0.f;
#pragma unroll
            for (int j = 0; j < 4; ++j) { v[j] = xr[64 * j]; s += (v[j].x * v[j].x + v[j].y * v[j].y) + (v[j].z * v[j].z + v[j].w * v[j].w); }
            const float inv = 1.0f / sqrtf(wave_sum(s) * (1.0f / D) + RMS_EPS);
            GAS unsigned long long* o8 = (GAS unsigned long long*)(F.HY + (size_t)row * D) + lane;
            float p[8];
#pragma unroll
            for (int e = 0; e < 8; ++e) p[e] = 0.f;
#pragma unroll
            for (int j = 0; j < 4; ++j) { const f32x4 h = (v[j] * inv) * ga[j] + sh[j];
                o8[64 * j] = (unsigned long long)pk2(h.x, h.y) | ((unsigned long long)pk2(h.z, h.w) << 32);
#pragma unroll
                for (int e = 0; e < 8; ++e) { const f32x4 w = *(const LAS f32x4*)(wf + e * 1024 + 256 * j + 4 * lane); p[e] += (h.x * w.x + h.y * w.y) + (h.z * w.z + h.w * w.w); } }
            const bool u5 = (lane & 32) != 0, u4 = (lane & 16) != 0, u3 = (lane & 8) != 0;
            float q0 = (u5 ? p[4] : p[0]) + __shfl_xor(u5 ? p[0] : p[4], 32);
            float q1 = (u5 ? p[5] : p[1]) + __shfl_xor(u5 ? p[1] : p[5], 32);
            float q2 = (u5 ? p[6] : p[2]) + __shfl_xor(u5 ? p[2] : p[6], 32);
            float q3 = (u5 ? p[7] : p[3]) + __shfl_xor(u5 ? p[3] : p[7], 32);
            float t0 = (u4 ? q2 : q0) + __shfl_xor(u4 ? q0 : q2, 16);
            float t1 = (u4 ? q3 : q1) + __shfl_xor(u4 ? q1 : q3, 16);
            float f = (u3 ? t1 : t0) + __shfl_xor(u3 ? t0 : t1, 8);
            f += __shfl_xor(f, 4); f += __shfl_xor(f, 2); f += __shfl_xor(f, 1);
            const int e = (lane >> 3) & 7;
            if ((lane & 7) == 0) { const float xg = f + F.b_forget[e]; const float t = -xg * LOG2E;
                const float lf = -(fmaxf(t, 0.f) + __builtin_amdgcn_logf(1.0f + __builtin_amdgcn_exp2f(-fabsf(t))));
                F.LOGF[(size_t)row * 8 + e] = lf; }
        }
    }
}

__device__ __forceinline__ void ph_scan(Frame& F) {
    const int gw = F.vcu * NWAVES + F.wave;
    if (gw >= BATCH * NH) return;
    const int b = gw >> 3, e = gw & 7, lane = F.lane, t0 = 32 * lane;
    float vals[32]; float run = 0.f;
#pragma unroll
    for (int i = 0; i < 32; ++i) { run += F.LOGF[((size_t)b * SEQ + t0 + i) * 8 + e]; vals[i] = run; }
    float incl = run;
#pragma unroll
    for (int o = 1; o < 64; o <<= 1) { const float n = __shfl_up(incl, o); if (lane >= o) incl += n; }
    const float off = incl - run;
#pragma unroll
    for (int i = 0; i < 32; ++i) F.F2[(size_t)gw * SEQ + t0 + i] = vals[i] + off;
}

typedef float f32x16 __attribute__((ext_vector_type(16)));
__device__ __forceinline__ int crow(int r, int hi) { return (r & 3) + 8 * (r >> 2) + 4 * hi; }
__device__ __forceinline__ bf16x8 pack8(const f32x16& p, int base) {
    v4u w; w.x = pg8::cvt_pk_bf16(p[base + 0], p[base + 1]); w.y = pg8::cvt_pk_bf16(p[base + 2], p[base + 3]); w.z = pg8::cvt_pk_bf16(p[base + 4], p[base + 5]); w.w = pg8::cvt_pk_bf16(p[base + 6], p[base + 7]);
    return __builtin_bit_cast(bf16x8, w);
}
#define MFMA32(a, b, c) __builtin_amdgcn_mfma_f32_32x32x16_bf16(a, b, c, 0, 0, 0)
template <int MODE>
__device__ __forceinline__ void attn_simple(Frame& F, int b, int h, int qblk) {
    const int lane = F.lane, r32 = lane & 31, hi = lane >> 5;
    const bf16* Qs = F.QKVZ + (size_t)(MODE * 4 + 0) * SEC_ELEMS; const bf16* Ks = F.QKVZ + (size_t)(MODE * 4 + 1) * SEC_ELEMS;
    const bf16* Vs = F.QKVZ + (size_t)(MODE * 4 + 2) * SEC_ELEMS; const bf16* Zs = F.QKVZ + (size_t)(MODE * 4 + 3) * SEC_ELEMS;
    const size_t rowb = (size_t)b * SEQ; const int qw0 = qblk * 32, t = qw0 + r32;
    bf16x8 qr[4];
#pragma unroll
    for (int d0 = 0; d0 < 4; ++d0) qr[d0] = *(const GAS bf16x8*)(Qs + (rowb + t) * DSEC + h * HD + d0 * 16 + hi * 8);
    f32x16 o[2]; o[0] = f32x16{}; o[1] = f32x16{};
    float carry = 0.f, mrun = -INFINITY, lsum = 0.f, Ft = 0.f;
    const float* F2row = F.F2 + (size_t)(b * NH + h) * SEQ;
    if (MODE == 1) Ft = F2row[t];
    bf16x8 ut0, ut1, ones;
    {   short a0[8], a1[8];
#pragma unroll
        for (int jj = 0; jj < 8; ++jj) { const int jk = 8 * (jj >> 2) + 4 * hi + (jj & 3); a0[jj] = (jk >= r32) ? (short)0x3F80 : (short)0; a1[jj] = (16 + jk >= r32) ? (short)0x3F80 : (short)0; }
        ut0 = (bf16x8){a0[0], a0[1], a0[2], a0[3], a0[4], a0[5], a0[6], a0[7]}; ut1 = (bf16x8){a1[0], a1[1], a1[2], a1[3], a1[4], a1[5], a1[6], a1[7]};
        ones = (bf16x8){(short)0x3F80, (short)0x3F80, (short)0x3F80, (short)0x3F80, (short)0x3F80, (short)0x3F80, (short)0x3F80, (short)0x3F80}; }
    const int jdiag = qw0 / 64;
    for (int jt = jdiag; jt >= 0; --jt) {
        const int kv0 = 64 * jt;
        f32x16 p0 = f32x16{}, p1 = f32x16{};
#pragma unroll
        for (int d0 = 0; d0 < 4; ++d0) {
            const bf16x8 k0 = *(const GAS bf16x8*)(Ks + (rowb + kv0 + r32) * DSEC + h * HD + d0 * 16 + hi * 8);
            const bf16x8 k1 = *(const GAS bf16x8*)(Ks + (rowb + kv0 + 32 + r32) * DSEC + h * HD + d0 * 16 + hi * 8);
            p0 = MFMA32(k0, qr[d0], p0); p1 = MFMA32(k1, qr[d0], p1); asm volatile("" ::: "memory"); }
        bf16x8 pa[4];
        if (MODE == 0) {
            f32x16 s0, s1;
#pragma unroll
            for (int r = 0; r < 16; ++r) { const int kv = kv0 + crow(r, hi);
                float z0 = fminf(p0[r], 126.f), z1 = fminf(p1[r], 126.f);
                float e0 = __builtin_amdgcn_logf(1.0f + __builtin_amdgcn_exp2f(z0)), e1 = __builtin_amdgcn_logf(1.0f + __builtin_amdgcn_exp2f(z1));
                if (jt == jdiag) { if (!(kv < t)) { e0 = 0.f; z0 = -INFINITY; } if (!(kv + 32 < t)) { e1 = 0.f; z1 = -INFINITY; } }
                s0[r] = e0; s1[r] = e1; p0[r] = z0; p1[r] = z1; }
            f32x16 cv;
#pragma unroll
            for (int r = 0; r < 16; ++r) cv[r] = carry;
            const bf16x8 l0 = pack8(s0, 0), l1 = pack8(s0, 8), l2 = pack8(s1, 0), l3 = pack8(s1, 8);
            f32x16 g0 = MFMA32(ut0, l0, cv); g0 = MFMA32(ut1, l1, g0); g0 = MFMA32(ones, l2, g0); g0 = MFMA32(ones, l3, g0);
            f32x16 g1 = MFMA32(ut0, l2, cv); g1 = MFMA32(ut1, l3, g1);
#pragma unroll
            for (int r = 0; r < 16; ++r) { p0[r] = __builtin_amdgcn_exp2f(p0[r] - g0[r]); p1[r] = __builtin_amdgcn_exp2f(p1[r] - g1[r]); }
            carry = __shfl(g0[0], r32);
        } else {
            float mx = -INFINITY;
#pragma unroll
            for (int r = 0; r < 16; ++r) { const int kv = kv0 + crow(r, hi);
                float z0 = p0[r] + (Ft - F2row[kv]), z1 = p1[r] + (Ft - F2row[kv + 32]);
                if (jt == jdiag) { if (kv > t) z0 = -INFINITY; if (kv + 32 > t) z1 = -INFINITY; }
                p0[r] = z0; p1[r] = z1; mx = fmaxf(mx, fmaxf(z0, z1)); }
            mx = fmaxf(mx, __shfl_xor(mx, 32));
            const float mnew = fmaxf(mrun, mx), alpha = __builtin_amdgcn_exp2f(mrun - mnew); mrun = mnew;
            float ps = 0.f;
#pragma unroll
            for (int r = 0; r < 16; ++r) { p0[r] = __builtin_amdgcn_exp2f(p0[r] - mnew); p1[r] = __builtin_amdgcn_exp2f(p1[r] - mnew); ps += p0[r] + p1[r]; }
            lsum = lsum * alpha + ps;
#pragma unroll
            for (int r = 0; r < 16; ++r) { const float ar = __shfl(alpha, crow(r, hi)); o[0][r] *= ar; o[1][r] *= ar; }
        }
        pa[0] = pack8(p0, 0); pa[1] = pack8(p0, 8); pa[2] = pack8(p1, 0); pa[3] = pack8(p1, 8);
#pragma unroll
        for (int d0 = 0; d0 < 2; ++d0)
#pragma unroll
            for (int s = 0; s < 4; ++s) { short vv[8];
#pragma unroll
                for (int jj = 0; jj < 8; ++jj) { const int kv = kv0 + 16 * s + 8 * (jj >> 2) + 4 * hi + (jj & 3); vv[jj] = (short)Vs[(rowb + kv) * DSEC + h * HD + 32 * d0 + r32]; }
                const bf16x8 vf = (bf16x8){vv[0], vv[1], vv[2], vv[3], vv[4], vv[5], vv[6], vv[7]};
                o[d0] = MFMA32(pa[s], vf, o[d0]); asm volatile("" ::: "memory"); }
        if (MODE == 0) { if (__all(carry > SB_STOP)) break; }
    }
    float inv = 1.f;
    if (MODE == 1) { const float lt = lsum + __shfl_xor(lsum, 32); inv = 1.0f / lt; }
#pragma unroll
    for (int r = 0; r < 16; ++r) { const int q = crow(r, hi); const float ir = (MODE == 1) ? __shfl(inv, q) : 1.f;
#pragma unroll
        for (int d0 = 0; d0 < 2; ++d0) { const size_t row = rowb + qw0 + q; const int col = h * HD + 32 * d0 + r32;
            const float zs = pg8::bf_lo((unsigned)Zs[row * DSEC + col]);
            F.HY[row * D + MODE * DSEC + col] = (bf16)f2bf(o[d0][r] * ir * zs); } }
}
__device__ __forceinline__ void ph_attn_simple(Frame& F) {
    const int gw = F.vcu * NWAVES + F.wave, NGW = F.G * NWAVES;
    for (int i = gw; i < 2 * BATCH * NH * (SEQ / 32); i += NGW) {
        const int qblk = (SEQ / 32 - 1) - (i >> 8), rest = i & 255, br = rest >> 7, bh = rest & 127;
        if (br == 0) attn_simple<0>(F, bh >> 3, bh & 7, qblk); else attn_simple<1>(F, bh >> 3, bh & 7, qblk);
    }
}

__device__ __forceinline__ void ph_norm(Frame& F) {
    const int gw = F.vcu * NWAVES + F.wave, NGW = F.G * NWAVES, lane = F.lane;
    f32x4 g[4];
#pragma unroll
    for (int j = 0; j < 4; ++j) g[j] = *(const GAS f32x4*)(F.final_g + 256 * j + 4 * lane);
    for (int row = gw; row < M; row += NGW) {
        GAS f32x4* xr = (GAS f32x4*)(F.out + (size_t)row * D) + lane;
        f32x4 v[4]; float s = 0.f;
#pragma unroll
        for (int j = 0; j < 4; ++j) { v[j] = xr[64 * j]; s += (v[j].x * v[j].x + v[j].y * v[j].y) + (v[j].z * v[j].z + v[j].w * v[j].w); }
        const float inv = 1.0f / sqrtf(wave_sum(s) * (1.0f / D) + RMS_EPS);
#pragma unroll
        for (int j = 0; j < 4; ++j) xr[64 * j] = (v[j] * inv) * g[j];
    }
}


struct Args { const float* in[12]; float* out; unsigned char* ws; int ph_lo, ph_hi, li, pad; };
constexpr int N_PHASES = 9;
__global__ void __launch_bounds__(NWAVES * 64, 2) mk_fwd(Args args) {
    extern __shared__ __attribute__((aligned(16))) unsigned char lds[];
    Frame F;
    F.lds = (LAS unsigned char*)lds;
    F.MISC = (volatile LAS unsigned*)(F.lds + MISC_OFF);
    F.tid = threadIdx.x; F.lane = F.tid & 63; F.wave = __builtin_amdgcn_readfirstlane(F.tid >> 6);
    F.G = gridDim.x; { const int bx = blockIdx.x; F.vcu = (F.G % 8 == 0) ? (bx % 8) * (F.G / 8) + bx / 8 : bx; }
    unsigned char* ws = args.ws;
    F.ctl = (gu32*)(ws + WS_CTL);
    F.x = args.in[0]; F.c = args.in[1]; F.w_ada = args.in[2]; F.b_ada = args.in[3]; F.norm_g = args.in[4]; F.w_in = args.in[5]; F.b_forget = args.in[6];
    F.w_o_sb = args.in[7]; F.w_o_fox = args.in[8]; F.b_gate = args.in[9]; F.w_out = args.in[10]; F.final_g = args.in[11]; F.out = args.out;
    F.MOD = (float*)(ws + WS_MOD); F.LOGF = (float*)(ws + WS_LOGF); F.F2 = (float*)(ws + WS_F2); F.WF = (float*)(ws + WS_WF);
    F.WIN_T = (bf16*)(ws + WS_WIN); F.WO_T = (bf16*)(ws + WS_WO); F.WOUT_T = (bf16*)(ws + WS_WOUT); F.HY = (bf16*)(ws + WS_HY);
    F.QKVZ = (bf16*)(ws + WS_QKVZ); F.GATES = (bf16*)(ws + WS_GATES); F.MERGED = (bf16*)(ws + WS_MERGED);
    for (int u = F.tid; u < (LDS_BYTES - LDSCTL_OFF) / 4; u += NWAVES * 64) ((LAS unsigned*)(F.lds + LDSCTL_OFF))[u] = 0u;
    __syncthreads();
    XcdBarrier bar = xcd_barrier_post((unsigned*)(F.ctl + CW_BAR), F.MISC + 8);
    const int lo = args.ph_lo, hi = args.ph_hi;
#ifndef PH_MASK
#define PH_MASK 0x1ff
#endif
#define IN(k) (((PH_MASK >> (k)) & 1) && lo <= (k) && (k) < hi)
#define GRID_BAR() xcd_barrier(bar)
    if (IN(0)) { ph_p0a(F); GRID_BAR(); }
    if (IN(1)) { ph_p0b(F); GRID_BAR(); }
    if (IN(2)) ph_scan(F);
    if (IN(3)) {
        pg8::Gemm g{F.HY, F.WIN_T, M, NPROJ, D, D, D}; pg8::StaticOrder S; S.init(M, NPROJ, F.G, (int)blockIdx.x);
        pg8::EpiProj E{F.QKVZ, SEC_ELEMS, F.GATES, F.b_gate, C2};
        pg8::gemm_phase<pg8::EpiProj, pg8::StaticOrder, true, true>(F.lds + RING_OFF, g, S, E);
        GRID_BAR();
    }
    if (IN(4)) { ph_attn_simple(F); GRID_BAR(); }
    if (IN(5)) {
        pg8::Gemm g{F.HY, F.WO_T, M, D, DSEC, D, D}; pg8::StaticOrder S; S.init(M, D, F.G, (int)blockIdx.x);
        pg8::EpiGateF32 E{F.out, F.GATES, 0};
        pg8::gemm_phase<pg8::EpiGateF32, pg8::StaticOrder, true, true>(F.lds + RING_OFF, g, S, E);
        GRID_BAR();
    }
    if (IN(6)) {
        pg8::Gemm g{F.HY + DSEC, F.WO_T + DSEC, M, D, DSEC, D, D}; pg8::StaticOrder S; S.init(M, D, F.G, (int)blockIdx.x);
        pg8::EpiMerge E{F.out, F.GATES, 1024, F.MERGED};
        pg8::gemm_phase<pg8::EpiMerge, pg8::StaticOrder, true, true>(F.lds + RING_OFF, g, S, E);
        GRID_BAR();
    }
    if (IN(7)) {
        pg8::Gemm g{F.MERGED, F.WOUT_T, M, D, D, D, D}; pg8::StaticOrder S; S.init(M, D, F.G, (int)blockIdx.x);
        pg8::EpiResid E{F.x, F.MOD, F.out, SEQ};
        pg8::gemm_phase<pg8::EpiResid, pg8::StaticOrder, true, true>(F.lds + RING_OFF, g, S, E);
        GRID_BAR();
    }
    if (IN(8)) ph_norm(F);
#undef IN
}

extern "C" void kernel_launch(void* const* d_in, const int* in_sizes, int n_in, void* d_out, int out_size, void* d_ws, size_t ws_size, hipStream_t stream) {
    static int grid = 0;
    if (grid == 0) {
        if (n_in != 12 || in_sizes[0] != M * D || out_size != M * D || ws_size < WS_END) { fprintf(stderr, "kernel_launch: shape/workspace mismatch: n_in %d in0 %d out %d ws %zu (need %zu)\n", n_in, n_in > 0 ? in_sizes[0] : -1, out_size, ws_size, (size_t)WS_END); grid = -1; return; }
        int dev = 0, cus = 0, per_cu = 0;
        if (hipGetDevice(&dev) != hipSuccess || hipDeviceGetAttribute(&cus, hipDeviceAttributeMultiprocessorCount, dev) != hipSuccess) { grid = -1; return; }
        if (hipFuncSetAttribute((const void*)mk_fwd, hipFuncAttributeMaxDynamicSharedMemorySize, LDS_BYTES) != hipSuccess) { fprintf(stderr, "kernel_launch: hipFuncSetAttribute failed\n"); grid = -1; return; }
        if (hipOccupancyMaxActiveBlocksPerMultiprocessor(&per_cu, (const void*)mk_fwd, NWAVES * 64, LDS_BYTES) != hipSuccess || per_cu < 1) { fprintf(stderr, "kernel_launch: occupancy query says %d\n", per_cu); per_cu = 1; }
        (void)hipGetLastError();
        grid = cus * (per_cu < 1 ? 1 : 1);
    }
    if (grid < 0) return;
    (void)hipMemsetAsync((char*)d_ws + WS_CTL, 0, CTL_ZERO_BYTES, stream);
    Args a{};
    for (int i = 0; i < 12; ++i) a.in[i] = (const float*)d_in[i];
    a.out = (float*)d_out; a.ws = (unsigned char*)d_ws;
    a.ph_lo = 0; a.ph_hi = N_PHASES; a.li = 0;
    hipLaunchKernelGGL(mk_fwd, dim3(grid), dim3(NWAVES * 64), LDS_BYTES, stream, a);
}
```

```cpp
#include <hip/hip_runtime.h>
#include <cstdio>
#include <cstdint>
#include <cmath>
namespace pg8 {
#define PG8_LAS __attribute__((address_space(3)))
typedef unsigned short bf16_t;
typedef short bf16x8 __attribute__((ext_vector_type(8)));
typedef float f32x4 __attribute__((ext_vector_type(4)));
typedef unsigned u32x4 __attribute__((ext_vector_type(4)));
constexpr int BM = 256, BK = 64, HALF = 128, HTB = HALF * BK * 2  , STAGE_BYTES = 8 * HTB, NXCD = 8, WGM = 8;

__host__ __device__ __forceinline__ int lds_byte(int r, int c) { const int st = (r >> 4) * 2 + (c >> 5), rr = r & 15, cc = c & 31, ob = rr * 64 + cc * 2; return st * 1024 + (ob ^ (((ob >> 9) & 1) << 5)); }
__host__ __device__ __forceinline__ void stage_rc(int b, int& R, int& C) { const int st = b / 1024, sb = b % 1024, swz = sb ^ (((sb >> 9) & 1) << 5); R = (st >> 1) * 16 + swz / 64; C = (st & 1) * 32 + (swz % 64) / 2; }
__host__ __device__ __forceinline__ int perm32(int rho) { const int n = rho >> 4, i = rho & 15; return 8 * (i >> 2) + 4 * n + (i & 3); }

struct Unit { int pm, pn; };
struct Gemm { const bf16_t* A; const bf16_t* Bt; int M, N, K, lda, ldb; };

struct StaticOrder {
    int nM, nN, nwg, G, c;
    __host__ __device__ void init(int M, int N, int G_, int c_) { nM = M / BM; nN = N / BM; nwg = nM * nN; G = G_; c = c_; }
    __host__ __device__ bool next(int i, Unit& u) const {
        const long L = (long)i * G + c; if (L >= nwg) return false;
        int wgid = (int)L; { const int q = nwg / NXCD, r = nwg % NXCD, xcd = wgid % NXCD, off = wgid / NXCD; wgid = (xcd < r ? xcd * (q + 1) : r * (q + 1) + (xcd - r) * q) + off; }
        const int nig = WGM * nN, gid = wgid / nig, fm = gid * WGM, gsz = (nM - fm) < WGM ? (nM - fm) : WGM;
        u.pm = fm + ((wgid % nig) % gsz); u.pn = (wgid % nig) / gsz; return true;
    }
    __device__ __forceinline__ void a_ready(const Unit&) const {}
    __device__ __forceinline__ void done(const Unit&) const {}
};


__device__ __forceinline__ unsigned cvt_pk_bf16(float lo, float hi) { unsigned r; asm volatile("v_cvt_pk_bf16_f32 %0, %1, %2" : "=v"(r) : "v"(lo), "v"(hi)); return r; }
__device__ __forceinline__ float bf_lo(unsigned w) { return __builtin_bit_cast(float, w << 16); }
__device__ __forceinline__ float bf_hi(unsigned w) { return __builtin_bit_cast(float, w & 0xffff0000u); }
__device__ __forceinline__ float sigmoid_f(float v) { return __builtin_amdgcn_rcpf(1.0f + __builtin_amdgcn_exp2f(-1.4426950408889634f * v)); }

struct EpiProj {
    static constexpr bool PERM = true, AFTER_DRAIN = false;
    bf16_t* QKVZ; size_t sec_stride; bf16_t* GATES; const float* b_gate; float qscale;
    __device__ __forceinline__ void operator()(const f32x4 (&acc)[2][2][4][2], const Unit& u, int wr, int wc, int fr, int fq) const {
        const int sec = u.pn >> 1; const int row0 = u.pm * BM + wr * 64 + fr;
        bf16_t* base; int ldc, col0; int mode; float sc = 1.f;
        if (sec < 8) { base = QKVZ + (size_t)sec * sec_stride; ldc = 512; col0 = (u.pn & 1) * 256 + wc * 32 + 8 * fq; mode = ((sec & 3) == 3) ? 1 : 0; if ((sec & 3) == 0) sc = qscale; }
        else { base = GATES; ldc = 2048; col0 = (u.pn - 16) * 256 + wc * 32 + 8 * fq; mode = 2; }
        f32x4 bv[2][2];
#pragma unroll
        for (int bj = 0; bj < 2; ++bj)
#pragma unroll
            for (int n = 0; n < 2; ++n) bv[bj][n] = (mode == 2) ? *(const f32x4*)(b_gate + col0 + bj * HALF + 4 * n) : (f32x4){0.f, 0.f, 0.f, 0.f};
#pragma unroll
        for (int ai = 0; ai < 2; ++ai)
#pragma unroll
            for (int m = 0; m < 4; ++m) { bf16_t* rowp = base + (size_t)(row0 + ai * HALF + m * 16) * ldc + col0;
#pragma unroll
                for (int bj = 0; bj < 2; ++bj) { f32x4 v0 = acc[ai][bj][m][0] + bv[bj][0], v1 = acc[ai][bj][m][1] + bv[bj][1];
                    if (mode != 0) {
#pragma unroll
                        for (int e = 0; e < 4; ++e) { const float s0 = sigmoid_f(v0[e]), s1 = sigmoid_f(v1[e]); v0[e] = (mode == 2) ? s0 : v0[e] * s0; v1[e] = (mode == 2) ? s1 : v1[e] * s1; } }
                    v0 = v0 * sc; v1 = v1 * sc; u32x4 w; w.x = cvt_pk_bf16(v0[0], v0[1]); w.y = cvt_pk_bf16(v0[2], v0[3]); w.z = cvt_pk_bf16(v1[0], v1[1]); w.w = cvt_pk_bf16(v1[2], v1[3]);
                    *(u32x4*)(rowp + bj * HALF) = w; } }
    }
};
struct EpiGateF32 {
    static constexpr bool PERM = false, AFTER_DRAIN = false;
    float* T; const bf16_t* G; int goff;
    __device__ __forceinline__ void operator()(const f32x4 (&acc)[2][2][4][2], const Unit& u, int wr, int wc, int fr, int fq) const {
        const int row0 = u.pm * BM + wr * 64 + fr, col0 = u.pn * BM + wc * 32 + 4 * fq;
#pragma unroll
        for (int ai = 0; ai < 2; ++ai)
#pragma unroll
            for (int m = 0; m < 4; ++m) { const size_t r = (size_t)(row0 + ai * HALF + m * 16);
#pragma unroll
                for (int bj = 0; bj < 2; ++bj)
#pragma unroll
                    for (int n = 0; n < 2; ++n) { const int c = col0 + bj * HALF + n * 16; const uint2 gw = *(const uint2*)(G + r * 2048 + goff + c);
                        f32x4 v = acc[ai][bj][m][n]; v[0] *= bf_lo(gw.x); v[1] *= bf_hi(gw.x); v[2] *= bf_lo(gw.y); v[3] *= bf_hi(gw.y);
                        *(f32x4*)(T + r * 1024 + c) = v; } }
    }
};
struct EpiMerge {
    static constexpr bool PERM = true, AFTER_DRAIN = false;
    const float* T; const bf16_t* G; int goff; bf16_t* O;
    __device__ __forceinline__ void operator()(const f32x4 (&acc)[2][2][4][2], const Unit& u, int wr, int wc, int fr, int fq) const {
        const int row0 = u.pm * BM + wr * 64 + fr, col0 = u.pn * BM + wc * 32 + 8 * fq;
#pragma unroll
        for (int ai = 0; ai < 2; ++ai)
#pragma unroll
            for (int m = 0; m < 4; ++m) { const size_t r = (size_t)(row0 + ai * HALF + m * 16);
#pragma unroll
                for (int bj = 0; bj < 2; ++bj) { const int c = col0 + bj * HALF; const u32x4 gw = *(const u32x4*)(G + r * 2048 + goff + c);
                    const f32x4 t0 = *(const f32x4*)(T + r * 1024 + c), t1 = *(const f32x4*)(T + r * 1024 + c + 4);
                    f32x4 v0 = acc[ai][bj][m][0], v1 = acc[ai][bj][m][1];
                    v0[0] = t0[0] + v0[0] * bf_lo(gw.x); v0[1] = t0[1] + v0[1] * bf_hi(gw.x); v0[2] = t0[2] + v0[2] * bf_lo(gw.y); v0[3] = t0[3] + v0[3] * bf_hi(gw.y);
                    v1[0] = t1[0] + v1[0] * bf_lo(gw.z); v1[1] = t1[1] + v1[1] * bf_hi(gw.z); v1[2] = t1[2] + v1[2] * bf_lo(gw.w); v1[3] = t1[3] + v1[3] * bf_hi(gw.w);
                    u32x4 w; w.x = cvt_pk_bf16(v0[0], v0[1]); w.y = cvt_pk_bf16(v0[2], v0[3]); w.z = cvt_pk_bf16(v1[0], v1[1]); w.w = cvt_pk_bf16(v1[2], v1[3]);
                    *(u32x4*)(O + r * 1024 + c) = w; } }
    }
};
struct EpiResid {
    static constexpr bool PERM = false, AFTER_DRAIN = false;
    const float* X; const float* MOD; float* O; int rows_per_b;
    __device__ __forceinline__ void operator()(const f32x4 (&acc)[2][2][4][2], const Unit& u, int wr, int wc, int fr, int fq) const {
        const int row0 = u.pm * BM + wr * 64 + fr, col0 = u.pn * BM + wc * 32 + 4 * fq;
        const int b = (u.pm * BM) / rows_per_b;
        f32x4 gv[2][2];
#pragma unroll
        for (int bj = 0; bj < 2; ++bj)
#pragma unroll
            for (int n = 0; n < 2; ++n) gv[bj][n] = *(const f32x4*)(MOD + (size_t)b * 3072 + 2048 + col0 + bj * HALF + n * 16);
#pragma unroll
        for (int ai = 0; ai < 2; ++ai)
#pragma unroll
            for (int m = 0; m < 4; ++m) { const size_t r = (size_t)(row0 + ai * HALF + m * 16);
#pragma unroll
                for (int bj = 0; bj < 2; ++bj)
#pragma unroll
                    for (int n = 0; n < 2; ++n) { const int c = col0 + bj * HALF + n * 16; const f32x4 xv = *(const f32x4*)(X + r * 1024 + c);
                        *(f32x4*)(O + r * 1024 + c) = xv + gv[bj][n] * acc[ai][bj][m][n]; } }
    }
};

template <class Epi, class Sched, bool ALIGN_EPI = false, bool SP2 = false>
__device__ __forceinline__ void gemm_phase(PG8_LAS unsigned char* lds, const Gemm g, const Sched& S, const Epi& E) {
    const int tid = threadIdx.x, wid = __builtin_amdgcn_readfirstlane(tid >> 6), lane = tid & 63, wr = wid >> 2, wc = wid & 3, fr = lane & 15, fq = lane >> 4;
    const int K = g.K, nt = K / BK;
    unsigned voffA[2], voffB[2];
#pragma unroll
    for (int i = 0; i < 2; ++i) { int R, C; stage_rc(tid * 16 + i * 8192, R, C); const int Rb = Epi::PERM ? ((R & ~31) + perm32(R & 31)) : R;
        voffA[i] = (unsigned)(R * g.lda + C) * 2u; voffB[i] = (unsigned)(Rb * g.ldb + C) * 2u; }
    const size_t kstep = (size_t)(BK * 2);
    const size_t hstepA = (size_t)HALF * g.lda * 2, hstepB = (size_t)HALF * g.ldb * 2;
    const size_t tstepA = 2 * hstepA, tstepB = 2 * hstepB;
    const unsigned ldsw = (unsigned)wid * 1024u;
    const int aoff = lds_byte(wr * 64 + fr, fq * 8), boff = lds_byte(wc * 32 + fr, fq * 8);
#define PG8_SA(b, h) (((b) * 2 + (h)) * HTB)
#define PG8_SB(b, h) ((4 + (b) * 2 + (h)) * HTB)
#define PG8_STAGE(bufoff, gbase, voff) do { _Pragma("unroll") for (int _i = 0; _i < 2; ++_i) \
        __builtin_amdgcn_global_load_lds((const unsigned*)((const char*)(gbase) + (voff)[_i]), (PG8_LAS unsigned*)(lds + (bufoff) + ldsw + _i * 8192), 16, 0, 0); } while (0)
#define PG8_LDA(dst, b, h) do { _Pragma("unroll") for (int m = 0; m < 4; ++m) _Pragma("unroll") for (int k = 0; k < 2; ++k) dst[m][k] = *(const PG8_LAS bf16x8*)(lds + PG8_SA(b, h) + aoff + m * 2048 + k * 1024); } while (0)
#define PG8_LDB(dst, b, h) do { _Pragma("unroll") for (int n = 0; n < 2; ++n) _Pragma("unroll") for (int k = 0; k < 2; ++k) dst[n][k] = *(const PG8_LAS bf16x8*)(lds + PG8_SB(b, h) + boff + n * 2048 + k * 1024); } while (0)
#define PG8_MMA(ai, bj, At, Bt) do { __builtin_amdgcn_s_setprio(1); _Pragma("unroll") for (int m = 0; m < 4; ++m) _Pragma("unroll") for (int n = 0; n < 2; ++n) _Pragma("unroll") for (int k = 0; k < 2; ++k) \
        acc[ai][bj][m][n] = __builtin_amdgcn_mfma_f32_16x16x32_bf16(Bt[n][k], At[m][k], acc[ai][bj][m][n], 0, 0, 0); __builtin_amdgcn_s_setprio(0); } while (0)
#define PG8_WAIT_V(n) asm volatile("s_waitcnt vmcnt(" #n ")" ::: "memory")
#define PG8_WAIT_L(n) asm volatile("s_waitcnt lgkmcnt(" #n ")" ::: "memory")
#define PG8_BAR __builtin_amdgcn_s_barrier()
#define PG8_SCHED __builtin_amdgcn_sched_barrier(0)
    Unit cur, nxt; int ui = 0;
    if (!S.next(0, cur)) return;
    f32x4 acc[2][2][4][2];
#pragma unroll
    for (int a = 0; a < 2; ++a)
#pragma unroll
        for (int b = 0; b < 2; ++b)
#pragma unroll
            for (int m = 0; m < 4; ++m)
#pragma unroll
                for (int n = 0; n < 2; ++n) acc[a][b][m][n] = (f32x4){0.f, 0.f, 0.f, 0.f};
    bf16x8 At[4][2], B0[2][2], B1[2][2];
    const char* cA = (const char*)g.A + (size_t)cur.pm * tstepA; const char* cB = (const char*)g.Bt + (size_t)cur.pn * tstepB;
    S.a_ready(cur);
    if constexpr (SP2) {
        PG8_STAGE(PG8_SB(0, 0), cB, voffB); PG8_STAGE(PG8_SB(0, 1), cB + hstepB, voffB); PG8_STAGE(PG8_SA(0, 0), cA, voffA); PG8_STAGE(PG8_SA(0, 1), cA + hstepA, voffA);
        if (wr == 1) PG8_BAR;
        PG8_WAIT_V(2); PG8_BAR;
        PG8_STAGE(PG8_SB(1, 0), cB + kstep, voffB); PG8_STAGE(PG8_SA(1, 0), cA + kstep, voffA); PG8_STAGE(PG8_SB(1, 1), cB + hstepB + kstep, voffB);
        PG8_WAIT_V(6); PG8_BAR;
    } else {
        PG8_STAGE(PG8_SB(0, 0), cB, voffB); PG8_STAGE(PG8_SA(0, 0), cA, voffA); PG8_STAGE(PG8_SB(0, 1), cB + hstepB, voffB); PG8_STAGE(PG8_SA(0, 1), cA + hstepA, voffA);
        if (wr == 1) PG8_BAR;
        PG8_WAIT_V(4); PG8_BAR;
        PG8_STAGE(PG8_SB(1, 0), cB + kstep, voffB); PG8_STAGE(PG8_SA(1, 0), cA + kstep, voffA); PG8_STAGE(PG8_SB(1, 1), cB + hstepB + kstep, voffB);
        PG8_WAIT_V(6); PG8_BAR;
    }
    for (;;) {
        const bool has_next = S.next(ui + 1, nxt);
        const char* nA = has_next ? (const char*)g.A + (size_t)nxt.pm * tstepA : cA; const char* nB = has_next ? (const char*)g.Bt + (size_t)nxt.pn * tstepB : cB;
        for (int t = 0; t < nt; t += 2) {
            const bool last = (t == nt - 2);
            const char* a1 = cA + (size_t)(t + 1) * kstep;
            const char* a2 = last ? nA : cA + (size_t)(t + 2) * kstep; const char* b2 = last ? nB : cB + (size_t)(t + 2) * kstep;
            const char* a3 = a2 + kstep; const char* b3 = b2 + kstep;
            if (last && has_next) S.a_ready(nxt);
            if constexpr (SP2) {
            PG8_LDB(B0, 0, 0); PG8_LDB(B1, 0, 1); PG8_SCHED; PG8_LDA(At, 0, 0); PG8_STAGE(PG8_SA(1, 1), a1 + hstepA, voffA);
            PG8_WAIT_V(8); PG8_WAIT_L(0); PG8_BAR; PG8_MMA(0, 0, At, B0); PG8_MMA(0, 1, At, B1); PG8_BAR; PG8_SCHED;
            PG8_LDA(At, 0, 1); PG8_STAGE(PG8_SB(0, 0), b2, voffB); PG8_STAGE(PG8_SB(0, 1), b2 + hstepB, voffB); PG8_STAGE(PG8_SA(0, 0), a2, voffA);
            PG8_WAIT_V(8); PG8_WAIT_L(0); PG8_BAR; PG8_MMA(1, 0, At, B0); PG8_MMA(1, 1, At, B1); PG8_BAR; PG8_SCHED;
            PG8_LDB(B0, 1, 0); PG8_LDB(B1, 1, 1); PG8_SCHED; PG8_LDA(At, 1, 0); PG8_STAGE(PG8_SA(0, 1), a2 + hstepA, voffA);
            PG8_WAIT_V(8); PG8_WAIT_L(0); PG8_BAR; PG8_MMA(0, 0, At, B0); PG8_MMA(0, 1, At, B1); PG8_BAR; PG8_SCHED;
            PG8_LDA(At, 1, 1); PG8_STAGE(PG8_SB(1, 0), b3, voffB); PG8_STAGE(PG8_SB(1, 1), b3 + hstepB, voffB); PG8_STAGE(PG8_SA(1, 0), a3, voffA);
            PG8_WAIT_V(8); PG8_WAIT_L(0); PG8_BAR; PG8_MMA(1, 0, At, B0); PG8_MMA(1, 1, At, B1); PG8_BAR; PG8_SCHED;
            } else {
            PG8_LDB(B0, 0, 0); PG8_SCHED; PG8_LDA(At, 0, 0); PG8_STAGE(PG8_SA(1, 1), a1 + hstepA, voffA);
            PG8_WAIT_L(8); PG8_BAR; PG8_WAIT_L(0); PG8_MMA(0, 0, At, B0); PG8_BAR; PG8_SCHED;
            PG8_LDB(B1, 0, 1); PG8_STAGE(PG8_SB(0, 0), b2, voffB);
            PG8_BAR; PG8_WAIT_L(0); PG8_MMA(0, 1, At, B1); PG8_BAR;
            PG8_LDA(At, 0, 1); PG8_STAGE(PG8_SA(0, 0), a2, voffA);
            PG8_BAR; PG8_WAIT_L(0); PG8_MMA(1, 0, At, B0); PG8_BAR; PG8_SCHED;
            PG8_STAGE(PG8_SB(0, 1), b2 + hstepB, voffB);
            PG8_WAIT_V(6); PG8_BAR; PG8_MMA(1, 1, At, B1); PG8_BAR;
            PG8_LDB(B0, 1, 0); PG8_SCHED; PG8_LDA(At, 1, 0); PG8_STAGE(PG8_SA(0, 1), a2 + hstepA, voffA);
            PG8_WAIT_L(8); PG8_BAR; PG8_WAIT_L(0); PG8_MMA(0, 0, At, B0); PG8_BAR; PG8_SCHED;
            PG8_LDB(B1, 1, 1); PG8_STAGE(PG8_SB(1, 0), b3, voffB);
            PG8_BAR; PG8_WAIT_L(0); PG8_MMA(0, 1, At, B1); PG8_BAR;
            PG8_LDA(At, 1, 1); PG8_STAGE(PG8_SA(1, 0), a3, voffA);
            PG8_BAR; PG8_WAIT_L(0); PG8_MMA(1, 0, At, B0); PG8_BAR; PG8_SCHED;
            PG8_STAGE(PG8_SB(1, 1), b3 + hstepB, voffB);
            PG8_WAIT_V(6); PG8_BAR; PG8_MMA(1, 1, At, B1); PG8_BAR;
            }
        }
        if constexpr (ALIGN_EPI) { if (wr == 0) PG8_BAR; }
        if constexpr (!Epi::AFTER_DRAIN) { E(acc, cur, wr, wc, fr, fq); S.done(cur); }
        if (!has_next) break;
#pragma unroll
        for (int a = 0; a < 2; ++a)
#pragma unroll
            for (int b = 0; b < 2; ++b)
#pragma unroll
                for (int m = 0; m < 4; ++m)
#pragma unroll
                    for (int n = 0; n < 2; ++n) acc[a][b][m][n] = (f32x4){0.f, 0.f, 0.f, 0.f};
        cur = nxt; cA = nA; cB = nB; ++ui;
        if constexpr (ALIGN_EPI) { if (wr == 1) PG8_BAR; }
    }
    PG8_WAIT_V(0);
    if constexpr (!ALIGN_EPI) { if (wr == 0) PG8_BAR; }
    PG8_BAR;
    if constexpr (Epi::AFTER_DRAIN) { E.fused(acc, cur, wr, wc, fr, fq, lds, wid, lane); S.done(cur); }
#undef PG8_SA
#undef PG8_SB
#undef PG8_STAGE
#undef PG8_LDA
#undef PG8_LDB
#undef PG8_MMA
#undef PG8_WAIT_V
#undef PG8_WAIT_L
#undef PG8_BAR
#undef PG8_SCHED
}
}

#define GAS __attribute__((address_space(1)))
#define LAS __attribute__((address_space(3)))
typedef unsigned short bf16;
typedef unsigned v4u __attribute__((ext_vector_type(4)));
typedef float f32x4 __attribute__((ext_vector_type(4)));
typedef short bf16x8 __attribute__((ext_vector_type(8)));
typedef GAS unsigned gu32;
typedef GAS unsigned long long gu64;
#define RLX_AGENT __ATOMIC_RELAXED, __HIP_MEMORY_SCOPE_AGENT
#define LDS_WAIT() asm volatile("s_waitcnt lgkmcnt(0)" ::: "memory")
#define VM_WAIT() asm volatile("s_waitcnt vmcnt(0)" ::: "memory")
__device__ __forceinline__ unsigned long long rt() { return __builtin_amdgcn_s_memrealtime(); }
__device__ __forceinline__ unsigned f2bf(float f) { unsigned u = __builtin_bit_cast(unsigned, f); return (u + 0x7fffu + ((u >> 16) & 1u)) >> 16; }
__device__ __forceinline__ unsigned pk2(float lo, float hi) { return f2bf(lo) | (f2bf(hi) << 16); }

#define XB_TMO      128
#define XB_XCNT(j)  (256  + 64 * (j))
#define XB_XSUB(j)  (1280 + 64 * (j))
#define XB_XGEN(j)  (2304 + 64 * (j))
#define XB_TOP      3328
#define XB_TOPGEN   3392
#define XCD_BAR_WORDS 3456
#define XB_SPIN_CAP (1u << 18)

__device__ __forceinline__ unsigned xb_ld(unsigned* p)              { return __hip_atomic_load(p, __ATOMIC_RELAXED, __HIP_MEMORY_SCOPE_AGENT); }
__device__ __forceinline__ unsigned xb_add(unsigned* p, unsigned v) { return __hip_atomic_fetch_add(p, v, __ATOMIC_RELAXED, __HIP_MEMORY_SCOPE_AGENT); }
__device__ __forceinline__ unsigned xb_xcc_id() { return (unsigned)__builtin_amdgcn_s_getreg((3 << 11) | 20) & 0xFu; }
#define XB_SPIN(cond, bar) do { unsigned _sp = 0; while (cond) { __builtin_amdgcn_s_sleep(1); \
    if ((++_sp & 255u) == 0u) { if (xb_ld(&(bar)[XB_TMO])) break; if (_sp > XB_SPIN_CAP) { atomicAdd(&(bar)[XB_TMO], 1u); break; } } } } while (0)

struct XcdBarrier {
    unsigned* bar; unsigned x;
    volatile LAS unsigned* st;
};

__device__ __forceinline__ XcdBarrier xcd_barrier_post(unsigned* bar, volatile LAS unsigned* st) {
    XcdBarrier b; b.bar = bar; b.x = xb_xcc_id(); b.st = st;
    if (threadIdx.x == 0) (void)xb_add(&bar[XB_XCNT(b.x)], 1u);
    return b;
}
__device__ __forceinline__ void xcd_barrier_complete(unsigned* bar, unsigned x, unsigned& nloc, unsigned& nx) {
    const unsigned G = gridDim.x * gridDim.y * gridDim.z;
    unsigned sum, cnt, mine, sp = 0u;
    for (;;) {
        sum = 0u; cnt = 0u; mine = 0u;
#pragma unroll
        for (unsigned j = 0; j < 16; ++j) { const unsigned c = xb_ld(&bar[XB_XCNT(j)]); sum += c; cnt += (c > 0u) ? 1u : 0u; mine = (j == x) ? c : mine; }
        if (sum == G) break;
        __builtin_amdgcn_s_sleep(1);
        if ((++sp & 255u) == 0u) { if (xb_ld(&bar[XB_TMO])) break; if (sp > XB_SPIN_CAP) { atomicAdd(&bar[XB_TMO], 1u); break; } }
    }
    nloc = mine > 0u ? mine : 1u; nx = cnt > 0u ? cnt : 1u;
}

__device__ __forceinline__ void xcd_barrier(const XcdBarrier& b) {
    asm volatile("s_waitcnt vmcnt(0)" ::: "memory");
    __syncthreads();
    if (threadIdx.x == 0) {
        unsigned* bar = b.bar;
        __builtin_amdgcn_s_waitcnt(0);
        unsigned nloc = b.st[0], nx = b.st[1];
        if (nloc == 0u) { xcd_barrier_complete(bar, b.x, nloc, nx); b.st[0] = nloc; b.st[1] = nx; }
        const unsigned old = xb_add(&bar[XB_XSUB(b.x)], 1u);
        const unsigned gen = old / nloc;
        if (old + 1u == (gen + 1u) * nloc) {
            __builtin_amdgcn_fence(__ATOMIC_RELEASE, "agent");
            asm volatile("s_waitcnt vmcnt(0)" ::: "memory");
            const unsigned og = xb_add(&bar[XB_TOP], 1u);
            const unsigned tg = og / nx;
            if (og + 1u == (tg + 1u) * nx) xb_add(&bar[XB_TOPGEN], 1u);
            else XB_SPIN(xb_ld(&bar[XB_TOPGEN]) == tg, bar);
            __builtin_amdgcn_fence(__ATOMIC_ACQUIRE, "agent");
            xb_add(&bar[XB_XGEN(b.x)], 1u);
            asm volatile("s_waitcnt vmcnt(0)" ::: "memory");
        } else {
            XB_SPIN(xb_ld(&bar[XB_XGEN(b.x)]) == gen, bar);
            __builtin_amdgcn_fence(__ATOMIC_ACQUIRE, "agent");
            asm volatile("s_waitcnt vmcnt(0)" ::: "memory");
        }
    }
    __syncthreads();
}


constexpr int NWAVES = 8;
constexpr int BATCH = 16, SEQ = 2048, D = 1024, M = BATCH * SEQ, NH = 8, HD = 64, DSEC = 512;
constexpr int DIN = 6152, NPROJ = 6144, NGATE = 2048;
constexpr float RMS_EPS = 1e-6f;
constexpr float LOG2E = 1.4426950408889634f;
constexpr float C2 = 0.125f * LOG2E;
constexpr float SB_STOP = 64.0f;

constexpr size_t MiB = 1u << 20;
constexpr size_t WS_CTL = 0, CTL_ZERO_BYTES = 1 * MiB;
constexpr size_t WS_MOD = 1 * MiB;
constexpr size_t WS_LOGF = 2 * MiB;
constexpr size_t WS_WIN = 4 * MiB;
constexpr size_t WS_WO = 16 * MiB;
constexpr size_t WS_WOUT = 18 * MiB;
constexpr size_t WS_WF = 20 * MiB;
constexpr size_t WS_FX = 24 * MiB;
constexpr size_t WS_HY = 32 * MiB;
constexpr size_t WS_QKVZ = 96 * MiB;
constexpr size_t SEC_ELEMS = (size_t)M * DSEC;
constexpr size_t WS_GATES = 352 * MiB;
constexpr size_t WS_MERGED = WS_QKVZ;
constexpr size_t WS_END = 480 * MiB;

constexpr int CW_BAR = 4096;

constexpr int RING_OFF = 0, RING_BYTES = 131072;
constexpr int LDSCTL_OFF = RING_BYTES, MISC_OFF = LDSCTL_OFF + 320;
constexpr int LDS_BYTES = 147456;

struct Frame {
    LAS unsigned char* lds;
    volatile LAS unsigned* MISC;
    gu32* ctl;
    int tid, lane, wave;
    int vcu, G;
    const float *x, *c, *w_ada, *b_ada, *norm_g, *w_in, *b_forget, *w_o_sb, *w_o_fox, *b_gate, *w_out, *final_g;
    float* out;
    float *MOD, *LOGF, *WF;
    bf16* FX;
    bf16 *WIN_T, *WO_T, *WOUT_T, *HY, *QKVZ, *GATES, *MERGED;
};

__device__ __forceinline__ float wave_sum(float v) {
#pragma unroll
    for (int o = 1; o < 64; o <<= 1) v += __shfl_xor(v, o);
    return v;
}

__device__ __forceinline__ void transpose_item(const float* W, int ldw, int src_col0, bf16* WT, int ldt, int dst_row0, int dst_col0, LAS float* scr, int kb, int nb, int lane) {
    const int k0 = 64 * kb, n0 = 32 * nb;
#pragma unroll 8
    for (int i = 0; i < 32; ++i) { const int kk = 2 * i + (lane >> 5); scr[kk * 33 + (lane & 31)] = W[(size_t)(k0 + kk) * ldw + src_col0 + n0 + (lane & 31)]; }
    LDS_WAIT(); asm volatile("" ::: "memory");
    const int c = lane & 7;
#pragma unroll
    for (int j = 0; j < 4; ++j) { const int n = (lane >> 3) + 8 * j; const LAS float* s = scr + (8 * c) * 33 + n;
        v4u o; o.x = pk2(s[0 * 33], s[1 * 33]); o.y = pk2(s[2 * 33], s[3 * 33]); o.z = pk2(s[4 * 33], s[5 * 33]); o.w = pk2(s[6 * 33], s[7 * 33]);
        *(GAS v4u*)(WT + (size_t)(dst_row0 + n0 + n) * ldt + dst_col0 + k0 + 8 * c) = o; }
    LDS_WAIT(); asm volatile("" ::: "memory");
}
__device__ __forceinline__ void ph_p0a(Frame& F) {
    if (blockIdx.x < 96) {
        LAS float* cl = (LAS float*)(F.lds + RING_OFF);
        for (int i = F.tid; i < 16 * 1024 / 4; i += NWAVES * 64) ((LAS f32x4*)cl)[i] = ((const GAS f32x4*)F.c)[i];
        __syncthreads();
        const int col = F.tid & 31, ks = F.tid >> 5, j = blockIdx.x * 32 + col;
        float acc[16];
#pragma unroll
        for (int b = 0; b < 16; ++b) acc[b] = 0.f;
#pragma unroll 4
        for (int i = 0; i < 64; ++i) { const int k = ks * 64 + i; const float w = F.w_ada[(size_t)k * 3072 + j];
#pragma unroll
            for (int b = 0; b < 16; ++b) acc[b] += cl[b * 1024 + k] * w; }
        LAS float* red = cl + 16384;
#pragma unroll
        for (int b = 0; b < 16; ++b) red[(ks * 16 + b) * 32 + col] = acc[b];
        __syncthreads();
        { const int b = F.tid >> 5; float s = 0.f;
#pragma unroll
          for (int k2 = 0; k2 < 16; ++k2) s += red[(k2 * 16 + b) * 32 + col];
          F.MOD[b * 3072 + j] = s + F.b_ada[j]; }
        __syncthreads();
    }
    { const int g = blockIdx.x * (NWAVES * 64) + F.tid; if (g < 8192) { const int e = g >> 10, k = g & 1023; F.WF[g] = F.w_in[(size_t)k * DIN + 4096 + e]; } }
    LAS float* scr = (LAS float*)(F.lds + RING_OFF + F.wave * 16384);
    const int gw = F.vcu * NWAVES + F.wave, NGW = F.G * NWAVES;
    constexpr int I_A = 16 * 128, I_B = 16 * 64, I_O = 8 * 32, I_W = 16 * 32;
    constexpr int NITEMS = I_A + I_B + 2 * I_O + I_W;
    for (int it = gw; it < NITEMS; it += NGW) {
        int r = it;
        if (r < I_A) { transpose_item(F.w_in, DIN, 0, F.WIN_T, 1024, 0, 0, scr, r / 128, r % 128, F.lane); continue; } r -= I_A;
        if (r < I_B) { transpose_item(F.w_in, DIN, 4104, F.WIN_T, 1024, 4096, 0, scr, r / 64, r % 64, F.lane); continue; } r -= I_B;
        if (r < I_O) { transpose_item(F.w_o_sb, 1024, 0, F.WO_T, 1024, 0, 0, scr, r / 32, r % 32, F.lane); continue; } r -= I_O;
        if (r < I_O) { transpose_item(F.w_o_fox, 1024, 0, F.WO_T, 1024, 0, 512, scr, r / 32, r % 32, F.lane); continue; } r -= I_O;
        transpose_item(F.w_out, 1024, 0, F.WOUT_T, 1024, 0, 0, scr, r / 32, r % 32, F.lane);
    }
}

__device__ __forceinline__ void ph_p0b(Frame& F) {
    LAS float* wf = (LAS float*)(F.lds + RING_OFF);
    for (int i = F.tid; i < 8192 / 4; i += NWAVES * 64) ((LAS f32x4*)wf)[i] = ((const GAS f32x4*)F.WF)[i];
    __syncthreads();
    const int gw = F.vcu * NWAVES + F.wave, NGW = F.G * NWAVES;
    const int lane = F.lane;
    for (int blk = gw; blk < M / 16; blk += NGW) {
        const int row0 = blk * 16, b = row0 / SEQ;
        f32x4 ga[4], sh[4];
#pragma unroll
        for (int j = 0; j < 4; ++j) { const int col = 256 * j + 4 * lane;
            const f32x4 g = *(const GAS f32x4*)(F.norm_g + col), sc = *(const GAS f32x4*)(F.MOD + b * 3072 + 1024 + col);
            ga[j] = g * (1.0f + sc); sh[j] = *(const GAS f32x4*)(F.MOD + b * 3072 + col); }
        for (int r = 0; r < 16; ++r) {
            const int row = row0 + r;
            const GAS f32x4* xr = (const GAS f32x4*)(F.x + (size_t)row * D) + lane;
            f32x4 v[4]; float s = 0.f;
#pragma unroll
            for (int j = 0; j < 4; ++j) { v[j] = xr[64 * j]; s += (v[j].x * v[j].x + v[j].y * v[j].y) + (v[j].z * v[j].z + v[j].w * v[j].w); }
            const float inv = 1.0f / sqrtf(wave_sum(s) * (1.0f / D) + RMS_EPS);
            GAS unsigned long long* o8 = (GAS unsigned long long*)(F.HY + (size_t)row * D) + lane;
            float p[8];
#pragma unroll
            for (int e = 0; e < 8; ++e) p[e] = 0.f;
#pragma unroll
            for (int j = 0; j < 4; ++j) { const f32x4 h = (v[j] * inv) * ga[j] + sh[j];
                o8[64 * j] = (unsigned long long)pk2(h.x, h.y) | ((unsigned long long)pk2(h.z, h.w) << 32);
#pragma unroll
                for (int e = 0; e < 8; ++e) { const f32x4 w = *(const LAS f32x4*)(wf + e * 1024 + 256 * j + 4 * lane); p[e] += (h.x * w.x + h.y * w.y) + (h.z * w.z + h.w * w.w); } }
            const bool u5 = (lane & 32) != 0, u4 = (lane & 16) != 0, u3 = (lane & 8) != 0;
            float q0 = (u5 ? p[4] : p[0]) + __shfl_xor(u5 ? p[0] : p[4], 32);
            float q1 = (u5 ? p[5] : p[1]) + __shfl_xor(u5 ? p[1] : p[5], 32);
            float q2 = (u5 ? p[6] : p[2]) + __shfl_xor(u5 ? p[2] : p[6], 32);
            float q3 = (u5 ? p[7] : p[3]) + __shfl_xor(u5 ? p[3] : p[7], 32);
            float t0 = (u4 ? q2 : q0) + __shfl_xor(u4 ? q0 : q2, 16);
            float t1 = (u4 ? q3 : q1) + __shfl_xor(u4 ? q1 : q3, 16);
            float f = (u3 ? t1 : t0) + __shfl_xor(u3 ? t0 : t1, 8);
            f += __shfl_xor(f, 4); f += __shfl_xor(f, 2); f += __shfl_xor(f, 1);
            const int e = (lane >> 3) & 7;
            if ((lane & 7) == 0) { const float xg = f + F.b_forget[e]; const float t = -xg * LOG2E;
                const float lf = -(fmaxf(t, 0.f) + __builtin_amdgcn_logf(1.0f + __builtin_amdgcn_exp2f(-fabsf(t))));
                F.LOGF[(size_t)row * 8 + e] = lf; }
        }
    }
}

__device__ __forceinline__ void ph_scan(Frame& F) {
    const int gw = F.vcu * NWAVES + F.wave;
    if (gw >= BATCH * NH) return;
    const int b = gw >> 3, e = gw & 7, lane = F.lane, t0 = 32 * lane;
    float vals[32]; float run = 0.f;
#pragma unroll
    for (int i = 0; i < 32; ++i) { run += F.LOGF[((size_t)b * SEQ + t0 + i) * 8 + e]; vals[i] = run; }
    float incl = run;
#pragma unroll
    for (int o = 1; o < 64; o <<= 1) { const float n = __shfl_up(incl, o); if (lane >= o) incl += n; }
    const float off = incl - run;
#pragma unroll
    for (int i = 0; i < 32; ++i) { const float G = -(vals[i] + off);
        const unsigned gh = f2bf(G); const float r1 = G - __builtin_bit_cast(float, gh << 16);
        const unsigned gm = f2bf(r1); const float r2 = r1 - __builtin_bit_cast(float, gm << 16); const unsigned gl = f2bf(r2);
        v4u o; o.x = gh | (gm << 16); o.y = gl | 0x3F800000u; o.z = 0x3F803F80u; o.w = 0u;
        *(GAS v4u*)(F.FX + ((size_t)gw * SEQ + t0 + i) * 8) = o; }
}

__device__ __forceinline__ void ph_norm(Frame& F) {
    const int gw = F.vcu * NWAVES + F.wave, NGW = F.G * NWAVES, lane = F.lane;
    f32x4 g[4];
#pragma unroll
    for (int j = 0; j < 4; ++j) g[j] = *(const GAS f32x4*)(F.final_g + 256 * j + 4 * lane);
    for (int row = gw; row < M; row += NGW) {
        GAS f32x4* xr = (GAS f32x4*)(F.out + (size_t)row * D) + lane;
        f32x4 v[4]; float s = 0.f;
#pragma unroll
        for (int j = 0; j < 4; ++j) { v[j] = xr[64 * j]; s += (v[j].x * v[j].x + v[j].y * v[j].y) + (v[j].z * v[j].z + v[j].w * v[j].w); }
        const float inv = 1.0f / sqrtf(wave_sum(s) * (1.0f / D) + RMS_EPS);
#pragma unroll
        for (int j = 0; j < 4; ++j) xr[64 * j] = (v[j] * inv) * g[j];
    }
}


namespace att {
typedef float f32x16 __attribute__((ext_vector_type(16)));
typedef short s16x4 __attribute__((ext_vector_type(4)));
typedef short v4i16_t __attribute__((ext_vector_type(4)));
typedef __attribute__((address_space(3))) const char* lds_cptr;
constexpr int NW = 8, QBLK = 32, QB = 256, KVBLK = 64, DM = 512;
constexpr int NSLOT = 3, SLOTB = 8192;
constexpr int LDS_K = 0, LDS_V = NSLOT * SLOTB, LDS_FX = 2 * NSLOT * SLOTB, LDS_ZERO = LDS_FX + NSLOT * 1024, LDS_FLAG = LDS_ZERO + 256, LDS_WS = LDS_FLAG + 256, LDS_OST = LDS_WS + NW * 256, LDS_BYTES = LDS_OST + NW * 4096;
constexpr int THRL = 8;
#define SBAR() __builtin_amdgcn_sched_barrier(0)
#define ATT_WAIT_BAR(N) asm volatile("s_waitcnt vmcnt(" #N ") lgkmcnt(0)\n\ts_barrier" ::: "memory")
__device__ __forceinline__ int crow(int r, int hi) { return (r & 3) + 8 * (r >> 2) + 4 * hi; }
__device__ __forceinline__ void glds16(const void* gsrc, unsigned lds_dst) { unsigned keep;
    asm volatile("s_mov_b32 %0, m0\n\ts_mov_b32 m0, %2\n\ts_nop 0\n\tglobal_load_lds_dwordx4 %1, off\n\ts_mov_b32 m0, %0" : "=&s"(keep) : "v"(gsrc), "s"(lds_dst) : "memory"); }
__device__ __forceinline__ s16x4 vtr(lds_cptr p) { return __builtin_bit_cast(s16x4, __builtin_amdgcn_ds_read_tr16_b64_v4i16((__attribute__((address_space(3))) v4i16_t*)p)); }
__device__ __forceinline__ unsigned cvtpk(float lo, float hi) { typedef float f2 __attribute__((ext_vector_type(2))); typedef __bf16 b2 __attribute__((ext_vector_type(2))); f2 v = {lo, hi}; b2 b = __builtin_convertvector(v, b2); return __builtin_bit_cast(unsigned, b); }
__device__ __forceinline__ bf16x8 pack8(const f32x16& p, int base) {
    v4u w; w.x = cvtpk(p[base + 0], p[base + 1]); w.y = cvtpk(p[base + 2], p[base + 3]); w.z = cvtpk(p[base + 4], p[base + 5]); w.w = cvtpk(p[base + 6], p[base + 7]);
    return __builtin_bit_cast(bf16x8, w); }
#define ATT_MFMA(a, b, c) __builtin_amdgcn_mfma_f32_32x32x16_bf16(a, b, c, 0, 0, 0)
#define MX3(a, b, c) __builtin_fmaxf(__builtin_fmaxf((a), (b)), (c))
__device__ __forceinline__ float bcast_lo(float v) { auto rr = __builtin_amdgcn_permlane32_swap(__float_as_uint(v), __float_as_uint(v), false, false); return __uint_as_float(rr[0]); }
__device__ __forceinline__ float rowmax32(const f32x16& p0, const f32x16& p1) {
    float a = MX3(p0[0], p0[1], p1[0]), b = MX3(p0[2], p0[3], p1[1]); a = MX3(a, p1[2], p1[3]);
#pragma unroll
    for (int r = 4; r < 16; r += 4) { a = MX3(a, p0[r], p0[r + 1]); b = MX3(b, p0[r + 2], p0[r + 3]); a = MX3(a, p1[r], p1[r + 1]); b = MX3(b, p1[r + 2], p1[r + 3]); }
    const float m = __builtin_fmaxf(a, b); auto rr = __builtin_amdgcn_permlane32_swap(__float_as_uint(m), __float_as_uint(m), false, false);
    return __builtin_fmaxf(__uint_as_float(rr[0]), __uint_as_float(rr[1])); }

__device__ __forceinline__ bf16x8 make_qx(float mref, int hi) {
    const float nm = -mref; const unsigned a = f2bf(nm); const float r1 = nm - __builtin_bit_cast(float, a << 16); const unsigned b = f2bf(r1); const float r2 = r1 - __builtin_bit_cast(float, b << 16); const unsigned c = f2bf(r2);
    v4u w; w.x = hi ? 0u : 0x3F803F80u; w.y = hi ? 0u : (0x3F80u | (a << 16)); w.z = hi ? 0u : (b | (c << 16)); w.w = 0u; return __builtin_bit_cast(bf16x8, w); }
struct Tensors { const bf16* Q; const bf16* K; const bf16* V; const bf16* Z; const bf16* FX; bf16* Y; int ycol0; };

template <int MODE>
__device__ __forceinline__ void attn_unit(int b, int h, int qb, const Tensors& T, char* shm) {
    int tid_ = threadIdx.x; asm volatile("" : "+v"(tid_));
    const int tid = tid_, lane = tid & 63, r32 = lane & 31, hi = lane >> 5; const int wid = __builtin_amdgcn_readfirstlane(tid >> 6);
    const long rowbase = (long)b * SEQ; const int q0 = qb * QB, NT = (q0 + QB) / KVBLK, j0 = NT - 1;
    const bf16* Qw = T.Q + (rowbase + q0 + wid * QBLK) * DM + h * HD;
    const bf16* Kh = T.K + rowbase * DM + h * HD; const bf16* Vh = T.V + rowbase * DM + h * HD;
    const unsigned lds0 = (unsigned)(uintptr_t)shm;
    LAS float* wsf = (LAS float*)((LAS char*)shm + LDS_WS) + wid * 64;
    const bf16* ksrc = Kh + (long)lane * DM + wid * 8;
    const bf16* vsrc = Vh + (long)(16 * (wid & 3) + (lane >> 2)) * DM + (wid >> 2) * 32 + (lane & 3) * 8;
    const bf16* fsrc = T.FX + ((long)(b * NH + h) * SEQ + lane) * 8;
    const unsigned kdst = lds0 + LDS_K + wid * 1024, vdst = lds0 + LDS_V + wid * 1024, fdst = lds0 + LDS_FX;
#define DMA_K(t, slotb) glds16(ksrc + (long)(t) * KVBLK * DM, (unsigned)__builtin_amdgcn_readfirstlane(kdst + (slotb)))
#define DMA_V(t, slotb) glds16(vsrc + (long)(t) * KVBLK * DM, (unsigned)__builtin_amdgcn_readfirstlane(vdst + (slotb)))
#define DMA_F(t, slotb) glds16(fsrc + (long)(t) * KVBLK * 8, (unsigned)__builtin_amdgcn_readfirstlane(fdst + ((slotb) >> 3)))
#define ISSUE(t, slotb) do { if (MODE == 1 && wid == 0) DMA_F(t, slotb); DMA_K(t, slotb); DMA_V(t, slotb); } while (0)
    const lds_cptr shm3 = (lds_cptr)shm;
    const lds_cptr kp0 = shm3 + LDS_K + hi * 1024 + r32 * 16;
    const lds_cptr vp0 = shm3 + LDS_V + ((lane >> 4) & 1) * 32 + (lane & 3) * 8 + (4 * hi + ((lane & 15) >> 2)) * 64;
    const lds_cptr zp = shm3 + LDS_ZERO;
    ISSUE(j0, 0); ISSUE(j0 - 1, SLOTB);
    bf16x8 qr[4];
#pragma unroll
    for (int d0 = 0; d0 < 4; ++d0) qr[d0] = *reinterpret_cast<const bf16x8*>(&Qw[(long)r32 * DM + d0 * 16 + hi * 8]);
    f32x16 o[2]; o[0] = f32x16{}; o[1] = f32x16{};
    float mhat = 0.f, l_reg = 0.f, carry = 0.f;
    const int qrel = wid * QBLK + r32;
    const int i0 = 3 - (wid >> 1);
    bf16x8 ut0, ut1, ones, qx;
    {   const short one = (short)0x3F80; short a0[8], a1[8];
#pragma unroll
        for (int jj = 0; jj < 8; ++jj) { const int jk = 8 * (jj >> 2) + 4 * hi + (jj & 3); a0[jj] = (jk >= r32) ? one : (short)0; a1[jj] = (16 + jk >= r32) ? one : (short)0; }
        ut0 = (bf16x8){a0[0], a0[1], a0[2], a0[3], a0[4], a0[5], a0[6], a0[7]}; ut1 = (bf16x8){a1[0], a1[1], a1[2], a1[3], a1[4], a1[5], a1[6], a1[7]};
        ones = (bf16x8){one, one, one, one, one, one, one, one};
        qx = make_qx(0.f, hi); }
    volatile LAS unsigned* flags = (volatile LAS unsigned*)(shm3 + LDS_FLAG);
    ATT_WAIT_BAR(2);
    int sl_cur = 0, sl_nxt = SLOTB, sl_n2 = 2 * SLOTB;
    bool stop = false;
#define STEP(JB, ISTEP) do { \
    const int j_ = j0 - (ISTEP); \
    if (j_ >= 2) ISSUE(j_ - 2, sl_n2); \
    bf16x8 kf[8]; { const lds_cptr kp = kp0 + sl_cur; \
        _Pragma("unroll") for (int d0 = 0; d0 < 4; ++d0) { kf[2 * d0] = *(const LAS bf16x8*)(kp + d0 * 2048); kf[2 * d0 + 1] = *(const LAS bf16x8*)(kp + d0 * 2048 + 512); } } \
    f32x16 p0, p1; \
    p0 = ATT_MFMA(kf[0], qr[0], f32x16{}); p1 = ATT_MFMA(kf[1], qr[0], f32x16{}); \
    _Pragma("unroll") for (int d0 = 1; d0 < 4; ++d0) { p0 = ATT_MFMA(kf[2 * d0], qr[d0], p0); p1 = ATT_MFMA(kf[2 * d0 + 1], qr[d0], p1); } \
    if (MODE == 1) { const lds_cptr fp = hi ? zp : (shm3 + LDS_FX + (sl_cur >> 3) + r32 * 16); const lds_cptr fp1 = hi ? zp : (shm3 + LDS_FX + (sl_cur >> 3) + 512 + r32 * 16); \
        const bf16x8 fx0 = *(const LAS bf16x8*)fp, fx1 = *(const LAS bf16x8*)fp1; p0 = ATT_MFMA(fx0, qx, p0); p1 = ATT_MFMA(fx1, qx, p1); } \
    bf16x8 pa0, pa1, pa2, pa3; \
    if (MODE == 0) { \
        f32x16 s0, s1; \
        _Pragma("unroll") for (int r = 0; r < 16; ++r) { \
            float z0 = __builtin_fminf(p0[r], 126.f), z1 = __builtin_fminf(p1[r], 126.f); \
            float e0 = __builtin_amdgcn_logf(1.0f + __builtin_amdgcn_exp2f(z0)), e1 = __builtin_amdgcn_logf(1.0f + __builtin_amdgcn_exp2f(z1)); \
            if ((JB) >= 0) { const int kv = 64 * (JB) + crow(r, hi); if (!(kv < qrel)) { e0 = 0.f; z0 = -INFINITY; } if (!(kv + 32 < qrel)) { e1 = 0.f; z1 = -INFINITY; } } \
            s0[r] = e0; s1[r] = e1; p0[r] = z0; p1[r] = z1; } \
        f32x16 cv; _Pragma("unroll") for (int r = 0; r < 16; ++r) cv[r] = carry; \
        const bf16x8 l0 = pack8(s0, 0), l1 = pack8(s0, 8), l2 = pack8(s1, 0), l3 = pack8(s1, 8); \
        f32x16 g0 = ATT_MFMA(ut0, l0, cv); g0 = ATT_MFMA(ut1, l1, g0); g0 = ATT_MFMA(ones, l2, g0); g0 = ATT_MFMA(ones, l3, g0); \
        f32x16 g1 = ATT_MFMA(ut0, l2, cv); g1 = ATT_MFMA(ut1, l3, g1); \
        _Pragma("unroll") for (int r = 0; r < 16; ++r) { p0[r] = __builtin_amdgcn_exp2f(p0[r] - g0[r]); p1[r] = __builtin_amdgcn_exp2f(p1[r] - g1[r]); } \
        carry = bcast_lo(g0[0]); \
    } else { \
        if ((JB) >= 0) { _Pragma("unroll") for (int r = 0; r < 16; ++r) { const int kv = 64 * (JB) + crow(r, hi); if (kv > qrel) p0[r] = -INFINITY; if (kv + 32 > qrel) p1[r] = -INFINITY; } } \
        const float rm = rowmax32(p0, p1); \
        const bool first = ((ISTEP) < 4) && ((ISTEP) == i0); \
        if (first || __any(rm > (float)THRL)) { \
            const float dl = first ? rm : __builtin_fmaxf(rm, 0.f); mhat += dl; \
            _Pragma("unroll") for (int r = 0; r < 16; ++r) { p0[r] -= dl; p1[r] -= dl; } \
            qx = make_qx(mhat, hi); \
            if (!first) { const float f = __builtin_amdgcn_exp2f(-dl); l_reg *= f; if (hi == 0) wsf[r32] = f; asm volatile("s_waitcnt lgkmcnt(0)" ::: "memory"); \
                _Pragma("unroll") for (int r = 0; r < 16; ++r) { const float fr = wsf[crow(r, hi)]; o[0][r] *= fr; o[1][r] *= fr; } } } \
        float sacc = 0.f; \
        _Pragma("unroll") for (int r = 0; r < 16; ++r) { p0[r] = __builtin_amdgcn_exp2f(p0[r]); p1[r] = __builtin_amdgcn_exp2f(p1[r]); sacc += p0[r] + p1[r]; } \
        l_reg += sacc; \
    } \
    pa0 = pack8(p0, 0); pa1 = pack8(p0, 8); pa2 = pack8(p1, 0); pa3 = pack8(p1, 8); SBAR(); \
    { const lds_cptr vp = vp0 + sl_cur; \
      _Pragma("unroll") for (int d0 = 0; d0 < 2; ++d0) { s16x4 lo[4], hh[4]; \
        _Pragma("unroll") for (int ks = 0; ks < 4; ++ks) { lo[ks] = vtr(vp + d0 * 4096 + ks * 1024); hh[ks] = vtr(vp + d0 * 4096 + ks * 1024 + 512); } \
        o[d0] = ATT_MFMA(pa0, ((bf16x8){lo[0][0], lo[0][1], lo[0][2], lo[0][3], hh[0][0], hh[0][1], hh[0][2], hh[0][3]}), o[d0]); \
        o[d0] = ATT_MFMA(pa1, ((bf16x8){lo[1][0], lo[1][1], lo[1][2], lo[1][3], hh[1][0], hh[1][1], hh[1][2], hh[1][3]}), o[d0]); \
        o[d0] = ATT_MFMA(pa2, ((bf16x8){lo[2][0], lo[2][1], lo[2][2], lo[2][3], hh[2][0], hh[2][1], hh[2][2], hh[2][3]}), o[d0]); \
        o[d0] = ATT_MFMA(pa3, ((bf16x8){lo[3][0], lo[3][1], lo[3][2], lo[3][3], hh[3][0], hh[3][1], hh[3][2], hh[3][3]}), o[d0]); } } \
    if (MODE == 0) { const bool done = __all(carry > SB_STOP) != 0; if (lane == 0) flags[((ISTEP) & 1) * 8 + wid] = done ? 1u : 0u; } \
    if (j_ >= 2) { ATT_WAIT_BAR(2); } else { ATT_WAIT_BAR(0); } \
    if (MODE == 0) { unsigned a_ = 1u; _Pragma("unroll") for (int w_ = 0; w_ < 8; ++w_) a_ &= flags[((ISTEP) & 1) * 8 + w_]; stop = (a_ != 0u); } \
    { const int t_ = sl_cur; sl_cur = sl_nxt; sl_nxt = sl_n2; sl_n2 = t_; } \
} while (0)
    STEP(3, 0);
    if (!stop) { STEP(2, 1);
    if (!stop) { STEP(1, 2);
    if (!stop) { STEP(0, 3);
    for (int i = 4; i < NT && !stop; ++i) { STEP(-1, i); } } } }
    if (MODE == 0) { ATT_WAIT_BAR(0); }
#undef STEP
    float rli[16];
    if (MODE == 1) {
        { auto rr = __builtin_amdgcn_permlane32_swap(__float_as_uint(l_reg), __float_as_uint(l_reg), false, false); l_reg = __uint_as_float(rr[0]) + __uint_as_float(rr[1]); }
        if (hi == 0) wsf[32 + r32] = l_reg; asm volatile("s_waitcnt lgkmcnt(0)" ::: "memory");
#pragma unroll
        for (int r = 0; r < 16; ++r) rli[r] = __builtin_amdgcn_rcpf(wsf[32 + crow(r, hi)]);
    } else {
#pragma unroll
        for (int r = 0; r < 16; ++r) rli[r] = 1.f;
    }
    const bf16* Zw = T.Z + (rowbase + q0 + wid * QBLK) * DM + h * HD;
    bf16* Yw = T.Y + (rowbase + q0 + wid * QBLK) * (long)D + T.ycol0 + h * HD;
    {   LAS bf16* stg = (LAS bf16*)((LAS char*)shm + LDS_OST) + wid * 2048;
#pragma unroll
        for (int r = 0; r < 16; ++r) { const int orow = crow(r, hi);
#pragma unroll
            for (int d0 = 0; d0 < 2; ++d0) { const float zs = __builtin_bit_cast(float, (unsigned)Zw[(long)orow * DM + d0 * 32 + r32] << 16);
                stg[orow * 64 + d0 * 32 + r32] = (bf16)f2bf(o[d0][r] * rli[r] * zs); } }
        asm volatile("s_waitcnt lgkmcnt(0)" ::: "memory");
#pragma unroll
        for (int i = 0; i < 4; ++i) { const int row = i * 8 + (lane >> 3), ch = lane & 7; const v4u v = *(const LAS v4u*)(stg + row * 64 + ch * 8); *(v4u*)(Yw + (long)row * D + ch * 8) = v; } }
    asm volatile("s_waitcnt lgkmcnt(0)\n\ts_barrier" ::: "memory");
#undef DMA_K
#undef DMA_V
#undef DMA_F
#undef ISSUE
}
#undef SBAR
}

__device__ __forceinline__ void ph_attn(Frame& F, char* base) {
    if (F.tid < 64) ((LAS unsigned*)(F.lds + RING_OFF + att::LDS_ZERO))[F.tid] = 0u;
    const att::Tensors TA{F.QKVZ + 0 * SEC_ELEMS, F.QKVZ + 1 * SEC_ELEMS, F.QKVZ + 2 * SEC_ELEMS, F.QKVZ + 3 * SEC_ELEMS, F.FX, F.HY, 0};
    const att::Tensors TB{F.QKVZ + 4 * SEC_ELEMS, F.QKVZ + 5 * SEC_ELEMS, F.QKVZ + 6 * SEC_ELEMS, F.QKVZ + 7 * SEC_ELEMS, F.FX, F.HY, DSEC};
    for (int v = F.vcu; v < 2 * BATCH * NH; v += F.G) {
        const int bh = v >> 1, half = v & 1, b = bh >> 3, h = bh & 7;
#pragma unroll 1
        for (int u = 0; u < 4; ++u) { const int qb = half ? ((u == 0) ? 6 : (u == 1) ? 5 : (u == 2) ? 2 : 1) : ((u == 0) ? 7 : (u == 1) ? 4 : (u == 2) ? 3 : 0);
#if !defined(ATT_ONLY) || ATT_ONLY == 1
            att::attn_unit<1>(b, h, qb, TB, base);
#endif
        }
#pragma unroll 1
        for (int u = 0; u < 4; ++u) { const int qb = half ? ((u == 0) ? 6 : (u == 1) ? 5 : (u == 2) ? 2 : 1) : ((u == 0) ? 7 : (u == 1) ? 4 : (u == 2) ? 3 : 0);
#if !defined(ATT_ONLY) || ATT_ONLY == 0
            att::attn_unit<0>(b, h, qb, TA, base);
#endif
        }
    }
}


struct Args { const float* in[12]; float* out; unsigned char* ws; int ph_lo, ph_hi, li, pad; };
constexpr int N_PHASES = 9;
__global__ void __launch_bounds__(NWAVES * 64, 2) mk_fwd(Args args) {
    extern __shared__ __attribute__((aligned(16))) unsigned char lds[];
    Frame F;
    F.lds = (LAS unsigned char*)lds;
    F.MISC = (volatile LAS unsigned*)(F.lds + MISC_OFF);
    F.tid = threadIdx.x; F.lane = F.tid & 63; F.wave = __builtin_amdgcn_readfirstlane(F.tid >> 6);
    F.G = gridDim.x; { const int bx = blockIdx.x; F.vcu = (F.G % 8 == 0) ? (bx % 8) * (F.G / 8) + bx / 8 : bx; }
    unsigned char* ws = args.ws;
    F.ctl = (gu32*)(ws + WS_CTL);
    F.x = args.in[0]; F.c = args.in[1]; F.w_ada = args.in[2]; F.b_ada = args.in[3]; F.norm_g = args.in[4]; F.w_in = args.in[5]; F.b_forget = args.in[6];
    F.w_o_sb = args.in[7]; F.w_o_fox = args.in[8]; F.b_gate = args.in[9]; F.w_out = args.in[10]; F.final_g = args.in[11]; F.out = args.out;
    F.MOD = (float*)(ws + WS_MOD); F.LOGF = (float*)(ws + WS_LOGF); F.FX = (bf16*)(ws + WS_FX); F.WF = (float*)(ws + WS_WF);
    F.WIN_T = (bf16*)(ws + WS_WIN); F.WO_T = (bf16*)(ws + WS_WO); F.WOUT_T = (bf16*)(ws + WS_WOUT); F.HY = (bf16*)(ws + WS_HY);
    F.QKVZ = (bf16*)(ws + WS_QKVZ); F.GATES = (bf16*)(ws + WS_GATES); F.MERGED = (bf16*)(ws + WS_MERGED);
    for (int u = F.tid; u < (LDS_BYTES - LDSCTL_OFF) / 4; u += NWAVES * 64) ((LAS unsigned*)(F.lds + LDSCTL_OFF))[u] = 0u;
    __syncthreads();
    XcdBarrier bar = xcd_barrier_post((unsigned*)(F.ctl + CW_BAR), F.MISC + 8);
    const int lo = args.ph_lo, hi = args.ph_hi;
#ifndef PH_MASK
#define PH_MASK 0x1ff
#endif
#define IN(k) (((PH_MASK >> (k)) & 1) && lo <= (k) && (k) < hi)
#define GRID_BAR() xcd_barrier(bar)
    if (IN(0)) { ph_p0a(F); GRID_BAR(); }
    if (IN(1)) { ph_p0b(F); GRID_BAR(); }
    if (IN(2)) ph_scan(F);
    if (IN(3)) {
        pg8::Gemm g{F.HY, F.WIN_T, M, NPROJ, D, D, D}; pg8::StaticOrder S; S.init(M, NPROJ, F.G, (int)blockIdx.x);
        pg8::EpiProj E{F.QKVZ, SEC_ELEMS, F.GATES, F.b_gate, C2};
        pg8::gemm_phase<pg8::EpiProj, pg8::StaticOrder, true, true>(F.lds + RING_OFF, g, S, E);
        GRID_BAR();
    }
    if (IN(4)) { ph_attn(F, (char*)lds + RING_OFF); GRID_BAR(); }
    if (IN(5)) {
        pg8::Gemm g{F.HY, F.WO_T, M, D, DSEC, D, D}; pg8::StaticOrder S; S.init(M, D, F.G, (int)blockIdx.x);
        pg8::EpiGateF32 E{F.out, F.GATES, 0};
        pg8::gemm_phase<pg8::EpiGateF32, pg8::StaticOrder, true, true>(F.lds + RING_OFF, g, S, E);
        GRID_BAR();
    }
    if (IN(6)) {
        pg8::Gemm g{F.HY + DSEC, F.WO_T + DSEC, M, D, DSEC, D, D}; pg8::StaticOrder S; S.init(M, D, F.G, (int)blockIdx.x);
        pg8::EpiMerge E{F.out, F.GATES, 1024, F.MERGED};
        pg8::gemm_phase<pg8::EpiMerge, pg8::StaticOrder, true, true>(F.lds + RING_OFF, g, S, E);
        GRID_BAR();
    }
    if (IN(7)) {
        pg8::Gemm g{F.MERGED, F.WOUT_T, M, D, D, D, D}; pg8::StaticOrder S; S.init(M, D, F.G, (int)blockIdx.x);
        pg8::EpiResid E{F.x, F.MOD, F.out, SEQ};
        pg8::gemm_phase<pg8::EpiResid, pg8::StaticOrder, true, true>(F.lds + RING_OFF, g, S, E);
        GRID_BAR();
    }
    if (IN(8)) ph_norm(F);
#undef IN
}

extern "C" void kernel_launch(void* const* d_in, const int* in_sizes, int n_in, void* d_out, int out_size, void* d_ws, size_t ws_size, hipStream_t stream) {
    static int grid = 0;
    if (grid == 0) {
        if (n_in != 12 || in_sizes[0] != M * D || out_size != M * D || ws_size < WS_END) { fprintf(stderr, "kernel_launch: shape/workspace mismatch: n_in %d in0 %d out %d ws %zu (need %zu)\n", n_in, n_in > 0 ? in_sizes[0] : -1, out_size, ws_size, (size_t)WS_END); grid = -1; return; }
        int dev = 0, cus = 0, per_cu = 0;
        if (hipGetDevice(&dev) != hipSuccess || hipDeviceGetAttribute(&cus, hipDeviceAttributeMultiprocessorCount, dev) != hipSuccess) { grid = -1; return; }
        if (hipFuncSetAttribute((const void*)mk_fwd, hipFuncAttributeMaxDynamicSharedMemorySize, LDS_BYTES) != hipSuccess) { fprintf(stderr, "kernel_launch: hipFuncSetAttribute failed\n"); grid = -1; return; }
        if (hipOccupancyMaxActiveBlocksPerMultiprocessor(&per_cu, (const void*)mk_fwd, NWAVES * 64, LDS_BYTES) != hipSuccess || per_cu < 1) { fprintf(stderr, "kernel_launch: occupancy query says %d\n", per_cu); per_cu = 1; }
        (void)hipGetLastError();
        grid = cus * (per_cu < 1 ? 1 : 1);
    }
    if (grid < 0) return;
    (void)hipMemsetAsync((char*)d_ws + WS_CTL, 0, CTL_ZERO_BYTES, stream);
    Args a{};
    for (int i = 0; i < 12; ++i) a.in[i] = (const float*)d_in[i];
    a.out = (float*)d_out; a.ws = (unsigned char*)d_ws;
    a.ph_lo = 0; a.ph_hi = N_PHASES; a.li = 0;
    hipLaunchKernelGGL(mk_fwd, dim3(grid), dim3(NWAVES * 64), LDS_BYTES, stream, a);
}
```
